# Optimizing an MI355X kernel written in HIP

```python
import jax, jax.numpy as jnp
from jax import lax
import numpy as np

D_MODEL = 2048
BATCH = 4
SEQ = 4096
DEPTH = 2

CHUNK = 64
GMLP_WINDOW = 128
GMLP_HEAD_DIM = D_MODEL // 16
N_GMLP_HEADS = 8
D_GMLP = N_GMLP_HEADS * GMLP_HEAD_DIM
LRU_BLOCK_DIM = D_MODEL // 16
N_LRU_BLOCKS = 8
D_LRU = N_LRU_BLOCKS * LRU_BLOCK_DIM
D_MIX = D_GMLP + D_LRU
D_IN = 2 * D_GMLP + 2 * D_LRU
CONV_WIDTH = 4
LRU_C = 8.0
D_FF = 5632
EPS = 1e-6

kernel_name = "hymba_style_gmlp_rglru_macaron"


def rms_norm(x, g):
    xf = x.astype(jnp.float32)
    y = xf * lax.rsqrt(jnp.mean(xf * xf, axis=-1, keepdims=True) + EPS)
    return (y * g.astype(jnp.float32)).astype(x.dtype)


def swiglu(x, w_gate, w_up, w_down):
    return (jax.nn.silu(x @ w_gate) * (x @ w_up)) @ w_down


def gmlp_spatial_gate(u, v, v_gain, w_s, b_s):
    B, S, _ = u.shape
    v = rms_norm(v, v_gain)
    n_win = S // GMLP_WINDOW
    vh = v.reshape(B, n_win, GMLP_WINDOW, N_GMLP_HEADS, GMLP_HEAD_DIM)
    pos = jnp.arange(GMLP_WINDOW)
    mask = (pos[None, :] // CHUNK) <= (pos[:, None] // CHUNK)
    w = jnp.where(mask[None], w_s, jnp.zeros((), w_s.dtype))
    mixed = jnp.einsum('hqp,bnphd->bnqhd', w, vh) + b_s.T[:, :, None]
    return u * mixed.reshape(B, S, D_GMLP)


def causal_depthwise_conv(x, w, b):
    D = x.shape[-1]
    y = lax.conv_general_dilated(
        x, w[:, None, :].astype(x.dtype), window_strides=(1,),
        padding=[(CONV_WIDTH - 1, 0)],
        dimension_numbers=('NWC', 'WIO', 'NWC'),
        feature_group_count=D)
    return y + b


def rg_lru(x, w_a, b_a, w_x, b_x, lam):
    B, S, D = x.shape
    xf = x.astype(jnp.float32)
    xb = xf.reshape(B, S, N_LRU_BLOCKS, LRU_BLOCK_DIM)
    r = jax.nn.sigmoid(jnp.einsum('bshi,hij->bshj', xb, w_a.astype(jnp.float32)).reshape(B, S, D)
                       + b_a.astype(jnp.float32))
    i = jax.nn.sigmoid(jnp.einsum('bshi,hij->bshj', xb, w_x.astype(jnp.float32)).reshape(B, S, D)
                       + b_x.astype(jnp.float32))
    log_a = -LRU_C * r * jax.nn.softplus(-lam.astype(jnp.float32))
    a = jnp.exp(log_a)
    gated_x = jnp.sqrt(-jnp.expm1(2.0 * log_a)) * (i * xf)

    def combine(left, right):
        a_l, h_l = left
        a_r, h_r = right
        return a_l * a_r, a_r * h_l + h_r

    _, h = lax.associative_scan(combine, (a, gated_x), axis=1)
    return h.astype(x.dtype)


def hybrid_mixer(h, w_in, gmlp_v_gain, gmlp_w_s, gmlp_b_s, conv_w, conv_b,
                 lru_w_a, lru_b_a, lru_w_x, lru_b_x, lru_lambda, w_out):
    z = h @ w_in
    u, v, g, xr = jnp.split(z, [D_GMLP, 2 * D_GMLP, 2 * D_GMLP + D_LRU], axis=-1)
    y_a = gmlp_spatial_gate(jax.nn.gelu(u), jax.nn.gelu(v), gmlp_v_gain, gmlp_w_s, gmlp_b_s)
    xr = causal_depthwise_conv(xr, conv_w, conv_b)
    y_b = rg_lru(xr, lru_w_a, lru_b_a, lru_w_x, lru_b_x, lru_lambda) * jax.nn.gelu(g)
    return jnp.concatenate([y_a, y_b], axis=-1) @ w_out


def setup_inputs(seed: int = 0) -> dict:
    key = jax.random.key(seed)
    ks = jax.random.split(key, 26)
    L = DEPTH

    def nrm(k, shape, scale):
        return jax.random.normal(k, shape, jnp.float32) * scale

    def gain(k, shape):
        return 1.0 + 0.02 * jax.random.normal(k, shape, jnp.float32)

    a_pow_c = jax.random.uniform(ks[20], (L, D_LRU), jnp.float32, minval=0.9, maxval=0.999)
    a_base = a_pow_c ** (1.0 / LRU_C)
    lru_lambda = jnp.log(a_base) - jnp.log1p(-a_base)

    return {
        "x": nrm(ks[0], (BATCH, SEQ, D_MODEL), 1.0),
        "ffn1_norm": gain(ks[1], (L, D_MODEL)),
        "ffn1_w_gate": nrm(ks[2], (L, D_MODEL, D_FF), D_MODEL ** -0.5),
        "ffn1_w_up": nrm(ks[3], (L, D_MODEL, D_FF), D_MODEL ** -0.5),
        "ffn1_w_down": nrm(ks[4], (L, D_FF, D_MODEL), D_FF ** -0.5),
        "mix_norm": gain(ks[5], (L, D_MODEL)),
        "w_in": nrm(ks[6], (L, D_MODEL, D_IN), D_MODEL ** -0.5),
        "gmlp_v_gain": gain(ks[7], (L, D_GMLP)),
        "gmlp_w_s": nrm(ks[8], (L, N_GMLP_HEADS, GMLP_WINDOW, GMLP_WINDOW), GMLP_WINDOW ** -0.5),
        "gmlp_b_s": 1.0 + 0.01 * jax.random.normal(ks[9], (L, N_GMLP_HEADS, GMLP_WINDOW), jnp.float32),
        "conv_w": nrm(ks[10], (L, CONV_WIDTH, D_LRU), CONV_WIDTH ** -0.5),
        "conv_b": nrm(ks[11], (L, D_LRU), 0.01),
        "lru_w_a": nrm(ks[12], (L, N_LRU_BLOCKS, LRU_BLOCK_DIM, LRU_BLOCK_DIM), LRU_BLOCK_DIM ** -0.5),
        "lru_b_a": nrm(ks[13], (L, D_LRU), 0.01),
        "lru_w_x": nrm(ks[14], (L, N_LRU_BLOCKS, LRU_BLOCK_DIM, LRU_BLOCK_DIM), LRU_BLOCK_DIM ** -0.5),
        "lru_b_x": nrm(ks[15], (L, D_LRU), 0.01),
        "lru_lambda": lru_lambda,
        "w_out": nrm(ks[16], (L, D_MIX, D_MODEL), D_MIX ** -0.5),
        "ffn2_norm": gain(ks[17], (L, D_MODEL)),
        "ffn2_w_gate": nrm(ks[18], (L, D_MODEL, D_FF), D_MODEL ** -0.5),
        "ffn2_w_up": nrm(ks[19], (L, D_MODEL, D_FF), D_MODEL ** -0.5),
        "ffn2_w_down": nrm(ks[21], (L, D_FF, D_MODEL), D_FF ** -0.5),
        "final_norm": gain(ks[22], (D_MODEL,)),
    }


def reference(x, ffn1_norm, ffn1_w_gate, ffn1_w_up, ffn1_w_down, mix_norm, w_in,
              gmlp_v_gain, gmlp_w_s, gmlp_b_s, conv_w, conv_b, lru_w_a, lru_b_a,
              lru_w_x, lru_b_x, lru_lambda, w_out, ffn2_norm, ffn2_w_gate, ffn2_w_up,
              ffn2_w_down, final_norm):
    for l in range(DEPTH):
        x = x + 0.5 * swiglu(rms_norm(x, ffn1_norm[l]), ffn1_w_gate[l], ffn1_w_up[l], ffn1_w_down[l])
        x = x + hybrid_mixer(rms_norm(x, mix_norm[l]), w_in[l], gmlp_v_gain[l], gmlp_w_s[l],
                             gmlp_b_s[l], conv_w[l], conv_b[l], lru_w_a[l], lru_b_a[l],
                             lru_w_x[l], lru_b_x[l], lru_lambda[l], w_out[l])
        x = x + 0.5 * swiglu(rms_norm(x, ffn2_norm[l]), ffn2_w_gate[l], ffn2_w_up[l], ffn2_w_down[l])
    return rms_norm(x, final_norm)
```

```cpp
#include <hip/hip_runtime.h>
#include <cstdio>
#include <cstdint>
namespace pg8 {
#define PG8_LAS __attribute__((address_space(3)))
typedef unsigned short bf16_t;
typedef short bf16x8 __attribute__((ext_vector_type(8)));
typedef float f32x4 __attribute__((ext_vector_type(4)));
typedef unsigned u32x4 __attribute__((ext_vector_type(4)));
constexpr int BM = 256, BK = 64, HALF = 128, HTB = HALF * BK * 2  , STAGE_BYTES = 8 * HTB, NXCD = 8, WGM = 8;

__host__ __device__ __forceinline__ int lds_byte(int r, int c) { const int st = (r >> 4) * 2 + (c >> 5), rr = r & 15, cc = c & 31, ob = rr * 64 + cc * 2; return st * 1024 + (ob ^ (((ob >> 9) & 1) << 5)); }
__host__ __device__ __forceinline__ void stage_rc(int b, int& R, int& C) { const int st = b / 1024, sb = b % 1024, swz = sb ^ (((sb >> 9) & 1) << 5); R = (st >> 1) * 16 + swz / 64; C = (st & 1) * 32 + (swz % 64) / 2; }
__host__ __device__ __forceinline__ int perm32(int rho) { const int n = rho >> 4, i = rho & 15; return 8 * (i >> 2) + 4 * n + (i & 3); }

struct Unit { int pm, pn; };
struct Gemm { const bf16_t* A; const bf16_t* Bt; int M, N, K; };

struct StaticOrder {
    int nM, nN, nwg, G, c;
    __host__ __device__ void init(int M, int N, int G_, int c_) { nM = M / BM; nN = N / BM; nwg = nM * nN; G = G_; c = c_; }
    __host__ __device__ bool next(int i, Unit& u) const {
        const long L = (long)i * G + c; if (L >= nwg) return false;
        int wgid = (int)L; { const int q = nwg / NXCD, r = nwg % NXCD, xcd = wgid % NXCD, off = wgid / NXCD; wgid = (xcd < r ? xcd * (q + 1) : r * (q + 1) + (xcd - r) * q) + off; }
        const int nig = WGM * nN, gid = wgid / nig, fm = gid * WGM, gsz = (nM - fm) < WGM ? (nM - fm) : WGM;
        u.pm = fm + ((wgid % nig) % gsz); u.pn = (wgid % nig) / gsz; return true;
    }
    __device__ __forceinline__ void a_ready(const Unit&) const {}
    __device__ __forceinline__ void done(const Unit&) const {}
};
__device__ __forceinline__ unsigned cvt_pk_bf16(float lo, float hi) { unsigned r; asm volatile("v_cvt_pk_bf16_f32 %0, %1, %2" : "=v"(r) : "v"(lo), "v"(hi)); return r; }
typedef float f32x2 __attribute__((ext_vector_type(2)));
typedef unsigned u32x2 __attribute__((ext_vector_type(2)));
__device__ __forceinline__ float silu_f(float g) { return g * __builtin_amdgcn_rcpf(1.0f + __builtin_amdgcn_exp2f(-1.4426950408889634f * g)); }
__device__ __forceinline__ float gelu_tanh_f(float x) { const float t = x * (1.0f + 0.044715f * x * x); return x * __builtin_amdgcn_rcpf(1.0f + __builtin_amdgcn_exp2f(-2.3022081981f * t)); }

struct EpiSwiGLU {
    static constexpr bool PERM = true, AFTER_DRAIN = false;
    bf16_t* O; int ldc;
    __device__ __forceinline__ void operator()(const f32x4 (&acc)[2][2][4][2], const Unit& u, int wr, int wc, int fr, int fq) const {
        const int row0 = u.pm * BM + wr * 64 + fr, col0 = u.pn * HALF + wc * 32 + 8 * fq;
#pragma unroll
        for (int ai = 0; ai < 2; ++ai)
#pragma unroll
            for (int m = 0; m < 4; ++m) { bf16_t* rowp = O + (size_t)(row0 + ai * HALF + m * 16) * ldc + col0;
                const f32x4 g0 = acc[ai][0][m][0], g1 = acc[ai][0][m][1], u0 = acc[ai][1][m][0], u1 = acc[ai][1][m][1];
                f32x4 v0, v1;
#pragma unroll
                for (int j = 0; j < 4; ++j) { v0[j] = silu_f(g0[j]) * u0[j]; v1[j] = silu_f(g1[j]) * u1[j]; }
                u32x4 w; w.x = cvt_pk_bf16(v0[0], v0[1]); w.y = cvt_pk_bf16(v0[2], v0[3]); w.z = cvt_pk_bf16(v1[0], v1[1]); w.w = cvt_pk_bf16(v1[2], v1[3]);
                *(u32x4*)rowp = w; }
    }
};
struct EpiResid {
    static constexpr bool PERM = false, AFTER_DRAIN = false;
    const float* base; float* out; int ldc; float scale;
    __device__ __forceinline__ void operator()(const f32x4 (&acc)[2][2][4][2], const Unit& u, int wr, int wc, int fr, int fq) const {
        const int row0 = u.pm * BM + wr * 64 + fr, col0 = u.pn * BM + wc * 32 + 4 * fq;
#pragma unroll
        for (int ai = 0; ai < 2; ++ai) {
            f32x4 bs[4][2][2];
#pragma unroll
            for (int m = 0; m < 4; ++m) { const size_t off = (size_t)(row0 + ai * HALF + m * 16) * ldc + col0;
#pragma unroll
                for (int bj = 0; bj < 2; ++bj)
#pragma unroll
                    for (int n = 0; n < 2; ++n) bs[m][bj][n] = *(const f32x4*)(base + off + bj * HALF + n * 16); }
#pragma unroll
            for (int m = 0; m < 4; ++m) { const size_t off = (size_t)(row0 + ai * HALF + m * 16) * ldc + col0;
#pragma unroll
                for (int bj = 0; bj < 2; ++bj)
#pragma unroll
                    for (int n = 0; n < 2; ++n) *(f32x4*)(out + off + bj * HALF + n * 16) = bs[m][bj][n] + acc[ai][bj][m][n] * scale; }
            asm volatile("" ::: "memory"); }
    }
};
struct EpiDelta {
    static constexpr bool PERM = true, AFTER_DRAIN = false;
    bf16_t* O; int ldc;
    __device__ __forceinline__ void operator()(const f32x4 (&acc)[2][2][4][2], const Unit& u, int wr, int wc, int fr, int fq) const {
        const int row0 = u.pm * BM + wr * 64 + fr, col0 = u.pn * BM + wc * 32 + 8 * fq;
#pragma unroll
        for (int ai = 0; ai < 2; ++ai)
#pragma unroll
            for (int m = 0; m < 4; ++m) { bf16_t* rowp = O + (size_t)(row0 + ai * HALF + m * 16) * ldc + col0;
#pragma unroll
                for (int bj = 0; bj < 2; ++bj) { const f32x4 v0 = acc[ai][bj][m][0], v1 = acc[ai][bj][m][1];
                    u32x4 w; w.x = cvt_pk_bf16(v0[0], v0[1]); w.y = cvt_pk_bf16(v0[2], v0[3]); w.z = cvt_pk_bf16(v1[0], v1[1]); w.w = cvt_pk_bf16(v1[2], v1[3]);
                    *(u32x4*)(rowp + bj * HALF) = w; } }
    }
};
struct EpiWin {
    static constexpr bool PERM = true, AFTER_DRAIN = false;
    bf16_t* Z; int ldc; float* vpart;
    __device__ __forceinline__ void operator()(const f32x4 (&acc)[2][2][4][2], const Unit& u, int wr, int wc, int fr, int fq) const {
        const int row0 = u.pm * BM + wr * 64 + fr, col0 = u.pn * BM + wc * 32 + 8 * fq;
        const bool act = u.pn < 12, isv = (u.pn >= 4) && (u.pn < 8);
#pragma unroll
        for (int ai = 0; ai < 2; ++ai)
#pragma unroll
            for (int m = 0; m < 4; ++m) { const int row = row0 + ai * HALF + m * 16; bf16_t* rowp = Z + (size_t)row * ldc + col0; float ss = 0.f;
#pragma unroll
                for (int bj = 0; bj < 2; ++bj) { f32x4 v0 = acc[ai][bj][m][0], v1 = acc[ai][bj][m][1];
                    if (act) {
#pragma unroll
                        for (int j = 0; j < 4; ++j) { v0[j] = gelu_tanh_f(v0[j]); v1[j] = gelu_tanh_f(v1[j]); } }
                    ss += (v0[0] * v0[0] + v0[1] * v0[1]) + (v0[2] * v0[2] + v0[3] * v0[3]) + (v1[0] * v1[0] + v1[1] * v1[1]) + (v1[2] * v1[2] + v1[3] * v1[3]);
                    u32x4 w; w.x = cvt_pk_bf16(v0[0], v0[1]); w.y = cvt_pk_bf16(v0[2], v0[3]); w.z = cvt_pk_bf16(v1[0], v1[1]); w.w = cvt_pk_bf16(v1[2], v1[3]);
                    *(u32x4*)(rowp + bj * HALF) = w; }
                if (isv) { ss += __shfl_xor(ss, 16); ss += __shfl_xor(ss, 32); if (fq == 0) vpart[(size_t)row * 16 + (u.pn - 4) * 4 + wc] = ss; } }
    }
};
typedef int i32x4e __attribute__((ext_vector_type(4)));
struct EpiSwiGLU8 {
    static constexpr bool PERM = true, AFTER_DRAIN = false;
    bf16_t* O; int ldc; const float* sa; const float* sw;
    PG8_LAS const float* tab;
    __device__ __forceinline__ void operator()(const i32x4e (&acc)[2][2][4][2], const Unit& u, int wr, int wc, int fr, int fq) const {
        const int row0 = u.pm * BM + wr * 64 + fr, col0 = u.pn * HALF + wc * 32 + 8 * fq, brow = u.pn * BM + wc * 32 + 8 * fq;
        f32x4 sg0, sg1, su0, su1; float ra[2][4];
        if (tab) { PG8_LAS const float* t = tab + 256 + (u.pn >> 2) * 256 + wc * 32 + 8 * fq;
            sg0 = *(PG8_LAS const f32x4*)t; sg1 = *(PG8_LAS const f32x4*)(t + 4); su0 = *(PG8_LAS const f32x4*)(t + HALF); su1 = *(PG8_LAS const f32x4*)(t + HALF + 4);
#pragma unroll
            for (int ai = 0; ai < 2; ++ai)
#pragma unroll
                for (int m = 0; m < 4; ++m) ra[ai][m] = tab[wr * 64 + fr + ai * HALF + m * 16];
        } else { sg0 = *(const f32x4*)(sw + brow); sg1 = *(const f32x4*)(sw + brow + 4); su0 = *(const f32x4*)(sw + brow + HALF); su1 = *(const f32x4*)(sw + brow + HALF + 4);
#pragma unroll
            for (int ai = 0; ai < 2; ++ai)
#pragma unroll
                for (int m = 0; m < 4; ++m) ra[ai][m] = sa[row0 + ai * HALF + m * 16]; }
        const f32x4 ss0 = sg0 * su0, ss1 = sg1 * su1, nc0 = sg0 * (-1.4426950408889634f), nc1 = sg1 * (-1.4426950408889634f);
#pragma unroll
        for (int ai = 0; ai < 2; ++ai)
#pragma unroll
            for (int m = 0; m < 4; ++m) { bf16_t* rowp = O + (size_t)(row0 + ai * HALF + m * 16) * ldc + col0; const float r = ra[ai][m], r2 = r * r;
                const i32x4e ig0 = acc[ai][0][m][0], ig1 = acc[ai][0][m][1], iu0 = acc[ai][1][m][0], iu1 = acc[ai][1][m][1];
                u32x4 w;
#pragma unroll
                for (int h = 0; h < 2; ++h) {
                    const f32x2 ga = {(float)ig0[2 * h], (float)ig0[2 * h + 1]}, gb = {(float)ig1[2 * h], (float)ig1[2 * h + 1]}, ua = {(float)iu0[2 * h], (float)iu0[2 * h + 1]}, ub = {(float)iu1[2 * h], (float)iu1[2 * h + 1]};
                    const f32x2 na = {nc0[2 * h], nc0[2 * h + 1]}, nb = {nc1[2 * h], nc1[2 * h + 1]}, sa2 = {ss0[2 * h], ss0[2 * h + 1]}, sb2 = {ss1[2 * h], ss1[2 * h + 1]};
                    const f32x2 ta = (ga * na) * r, tb = (gb * nb) * r;
                    f32x2 ea, eb; ea.x = __builtin_amdgcn_exp2f(ta.x); ea.y = __builtin_amdgcn_exp2f(ta.y); eb.x = __builtin_amdgcn_exp2f(tb.x); eb.y = __builtin_amdgcn_exp2f(tb.y);
                    const f32x2 da = ea + 1.0f, db = eb + 1.0f;
                    f32x2 ca, cb; ca.x = __builtin_amdgcn_rcpf(da.x); ca.y = __builtin_amdgcn_rcpf(da.y); cb.x = __builtin_amdgcn_rcpf(db.x); cb.y = __builtin_amdgcn_rcpf(db.y);
                    const f32x2 va = ((ga * ua) * (sa2 * r2)) * ca, vb = ((gb * ub) * (sb2 * r2)) * cb;
                    const unsigned pa = cvt_pk_bf16(va.x, va.y), pb = cvt_pk_bf16(vb.x, vb.y);
                    if (h == 0) { w.x = pa; w.z = pb; } else { w.y = pa; w.w = pb; } }
                *(u32x4*)rowp = w; }
    }
};
struct EpiWin8 {
    static constexpr bool PERM = true, AFTER_DRAIN = false;
    bf16_t* Z; int ldc; float* vpart; const float* sa; const float* sw; int pnoff;
    PG8_LAS const float* tab;
    __device__ __forceinline__ void operator()(const i32x4e (&acc)[2][2][4][2], const Unit& u, int wr, int wc, int fr, int fq) const {
        const int gpn = u.pn + pnoff, row0 = u.pm * BM + wr * 64 + fr, lcol0 = u.pn * BM + wc * 32 + 8 * fq, col0 = lcol0 + pnoff * BM;
        const bool act = gpn < 12, isv = (gpn >= 4) && (gpn < 8);
        f32x4 s[2][2]; float ra[2][4];
        if (tab) { PG8_LAS const float* t = tab + 256 + (u.pn >> 2) * 256 + wc * 32 + 8 * fq;
#pragma unroll
            for (int bj = 0; bj < 2; ++bj) { s[bj][0] = *(PG8_LAS const f32x4*)(t + bj * HALF); s[bj][1] = *(PG8_LAS const f32x4*)(t + bj * HALF + 4); }
#pragma unroll
            for (int ai = 0; ai < 2; ++ai)
#pragma unroll
                for (int m = 0; m < 4; ++m) ra[ai][m] = tab[wr * 64 + fr + ai * HALF + m * 16];
        } else {
#pragma unroll
            for (int bj = 0; bj < 2; ++bj) { s[bj][0] = *(const f32x4*)(sw + lcol0 + bj * HALF); s[bj][1] = *(const f32x4*)(sw + lcol0 + bj * HALF + 4); }
#pragma unroll
            for (int ai = 0; ai < 2; ++ai)
#pragma unroll
                for (int m = 0; m < 4; ++m) ra[ai][m] = sa[row0 + ai * HALF + m * 16]; }
#pragma unroll
        for (int ai = 0; ai < 2; ++ai)
#pragma unroll
            for (int m = 0; m < 4; ++m) { const int row = row0 + ai * HALF + m * 16; bf16_t* rowp = Z + (size_t)row * ldc + col0; float ss = 0.f; const float r = ra[ai][m];
#pragma unroll
                for (int bj = 0; bj < 2; ++bj) { const i32x4e i0 = acc[ai][bj][m][0], i1 = acc[ai][bj][m][1]; const f32x4 s0 = s[bj][0] * r, s1 = s[bj][1] * r; f32x4 v0, v1;
#pragma unroll
                    for (int j = 0; j < 4; ++j) { v0[j] = (float)i0[j] * s0[j]; v1[j] = (float)i1[j] * s1[j]; }
                    if (act) {
#pragma unroll
                        for (int j = 0; j < 4; ++j) { v0[j] = gelu_tanh_f(v0[j]); v1[j] = gelu_tanh_f(v1[j]); } }
                    ss += (v0[0] * v0[0] + v0[1] * v0[1]) + (v0[2] * v0[2] + v0[3] * v0[3]) + (v1[0] * v1[0] + v1[1] * v1[1]) + (v1[2] * v1[2] + v1[3] * v1[3]);
                    u32x4 w; w.x = cvt_pk_bf16(v0[0], v0[1]); w.y = cvt_pk_bf16(v0[2], v0[3]); w.z = cvt_pk_bf16(v1[0], v1[1]); w.w = cvt_pk_bf16(v1[2], v1[3]);
                    *(u32x4*)(rowp + bj * HALF) = w; }
                if (isv) { ss += __shfl_xor(ss, 16); ss += __shfl_xor(ss, 32); if (fq == 0) vpart[(size_t)row * 16 + (gpn - 4) * 4 + wc] = ss; } }
    }
};
struct EpiDummyI8 {
    static constexpr bool PERM = true, AFTER_DRAIN = false;
    bf16_t* O; int ldc;
    __device__ __forceinline__ void operator()(const i32x4e (&acc)[2][2][4][2], const Unit& u, int wr, int wc, int fr, int fq) const {
        const int row0 = u.pm * BM + wr * 64 + fr, col0 = u.pn * BM + wc * 32 + 8 * fq;
#pragma unroll
        for (int ai = 0; ai < 2; ++ai)
#pragma unroll
            for (int m = 0; m < 4; ++m) { bf16_t* rowp = O + (size_t)(row0 + ai * HALF + m * 16) * ldc + col0;
#pragma unroll
                for (int bj = 0; bj < 2; ++bj) { const i32x4e v0 = acc[ai][bj][m][0], v1 = acc[ai][bj][m][1];
                    u32x4 w; w.x = cvt_pk_bf16((float)v0[0], (float)v0[1]); w.y = cvt_pk_bf16((float)v0[2], (float)v0[3]); w.z = cvt_pk_bf16((float)v1[0], (float)v1[1]); w.w = cvt_pk_bf16((float)v1[2], (float)v1[3]);
                    *(u32x4*)(rowp + bj * HALF) = w; } }
    }
};
typedef int i32x4 __attribute__((ext_vector_type(4)));
template <bool I8> struct AccSel { typedef f32x4 type; };
template <> struct AccSel<true> { typedef i32x4 type; };
template <class Epi, class Sched, bool ALIGN_EPI = false, bool SP2 = false, bool I8 = false>
__device__ __forceinline__ void gemm_phase(PG8_LAS unsigned char* lds, const Gemm g, const Sched& S, const Epi& E) {
    int tid = threadIdx.x; asm volatile("" : "+v"(tid));
    const int wid = __builtin_amdgcn_readfirstlane(tid >> 6), lane = tid & 63, wr = wid >> 2, wc = wid & 3, fr = lane & 15, fq = lane >> 4;
    const int K = g.K, nt = K / BK;
    unsigned voffA[2], voffB[2];
#pragma unroll
    for (int i = 0; i < 2; ++i) { int R, C; stage_rc(tid * 16 + i * 8192, R, C); const int Rb = Epi::PERM ? ((R & ~31) + perm32(R & 31)) : R;
        voffA[i] = (unsigned)(R * K + C) * 2u; voffB[i] = (unsigned)(Rb * K + C) * 2u; }
    const size_t kstep = (size_t)(BK * 2);
    const size_t hstep = (size_t)HALF * K * 2;
    const size_t tstep = 2 * hstep;
    const unsigned ldsw = (unsigned)wid * 1024u;
    const int aoff = lds_byte(wr * 64 + fr, fq * 8), boff = lds_byte(wc * 32 + fr, fq * 8);
#define PG8_SA(b, h) (((b) * 2 + (h)) * HTB)
#define PG8_SB(b, h) ((4 + (b) * 2 + (h)) * HTB)
#define PG8_STAGE(bufoff, gbase, voff) do { _Pragma("unroll") for (int _i = 0; _i < 2; ++_i) \
        __builtin_amdgcn_global_load_lds((const unsigned*)((const char*)(gbase) + (voff)[_i]), (PG8_LAS unsigned*)(lds + (bufoff) + ldsw + _i * 8192), 16, 0, 0); } while (0)
#define PG8_LDA(dst, b, h) do { _Pragma("unroll") for (int m = 0; m < 4; ++m) _Pragma("unroll") for (int k = 0; k < 2; ++k) dst[m][k] = *(const PG8_LAS bf16x8*)(lds + PG8_SA(b, h) + aoff + m * 2048 + k * 1024); } while (0)
#define PG8_LDB(dst, b, h) do { _Pragma("unroll") for (int n = 0; n < 2; ++n) _Pragma("unroll") for (int k = 0; k < 2; ++k) dst[n][k] = *(const PG8_LAS bf16x8*)(lds + PG8_SB(b, h) + boff + n * 2048 + k * 1024); } while (0)
#define PG8_MMA(ai, bj, At, Bt) do { __builtin_amdgcn_s_setprio(1); _Pragma("unroll") for (int m = 0; m < 4; ++m) _Pragma("unroll") for (int n = 0; n < 2; ++n) _Pragma("unroll") for (int k = 0; k < 2; ++k) { \
        if constexpr (I8) acc[ai][bj][m][n] = __builtin_amdgcn_mfma_i32_16x16x64_i8(__builtin_bit_cast(i32x4, Bt[n][k]), __builtin_bit_cast(i32x4, At[m][k]), acc[ai][bj][m][n], 0, 0, 0); \
        else acc[ai][bj][m][n] = __builtin_amdgcn_mfma_f32_16x16x32_bf16(Bt[n][k], At[m][k], acc[ai][bj][m][n], 0, 0, 0); } __builtin_amdgcn_s_setprio(0); } while (0)
#define PG8_WAIT_V(n) asm volatile("s_waitcnt vmcnt(" #n ")" ::: "memory")
#define PG8_WAIT_L(n) asm volatile("s_waitcnt lgkmcnt(" #n ")" ::: "memory")
#define PG8_BAR __builtin_amdgcn_s_barrier()
#define PG8_SCHED __builtin_amdgcn_sched_barrier(0)
    Unit cur, nxt; int ui = 0;
    if (!S.next(0, cur)) return;
    typedef typename AccSel<I8>::type acc_t;
    acc_t acc[2][2][4][2];
#pragma unroll
    for (int a = 0; a < 2; ++a)
#pragma unroll
        for (int b = 0; b < 2; ++b)
#pragma unroll
            for (int m = 0; m < 4; ++m)
#pragma unroll
                for (int n = 0; n < 2; ++n) acc[a][b][m][n] = (acc_t){0, 0, 0, 0};
    bf16x8 At[4][2], B0[2][2], B1[2][2];
    const char* cA = (const char*)g.A + (size_t)cur.pm * tstep; const char* cB = (const char*)g.Bt + (size_t)cur.pn * tstep;
    S.a_ready(cur);
    if constexpr (SP2) {
        PG8_STAGE(PG8_SB(0, 0), cB, voffB); PG8_STAGE(PG8_SB(0, 1), cB + hstep, voffB); PG8_STAGE(PG8_SA(0, 0), cA, voffA); PG8_STAGE(PG8_SA(0, 1), cA + hstep, voffA);
        if (wr == 1) PG8_BAR;
        PG8_WAIT_V(2); PG8_BAR;
        PG8_STAGE(PG8_SB(1, 0), cB + kstep, voffB); PG8_STAGE(PG8_SA(1, 0), cA + kstep, voffA); PG8_STAGE(PG8_SB(1, 1), cB + hstep + kstep, voffB);
        PG8_WAIT_V(6); PG8_BAR;
    } else {
        PG8_STAGE(PG8_SB(0, 0), cB, voffB); PG8_STAGE(PG8_SA(0, 0), cA, voffA); PG8_STAGE(PG8_SB(0, 1), cB + hstep, voffB); PG8_STAGE(PG8_SA(0, 1), cA + hstep, voffA);
        if (wr == 1) PG8_BAR;
        PG8_WAIT_V(4); PG8_BAR;
        PG8_STAGE(PG8_SB(1, 0), cB + kstep, voffB); PG8_STAGE(PG8_SA(1, 0), cA + kstep, voffA); PG8_STAGE(PG8_SB(1, 1), cB + hstep + kstep, voffB);
        PG8_WAIT_V(6); PG8_BAR;
    }
    for (;;) {
        const bool has_next = S.next(ui + 1, nxt);
        const char* nA = has_next ? (const char*)g.A + (size_t)nxt.pm * tstep : cA; const char* nB = has_next ? (const char*)g.Bt + (size_t)nxt.pn * tstep : cB;
        for (int t = 0; t < nt; t += 2) {
            const bool last = (t == nt - 2);
            const char* a1 = cA + (size_t)(t + 1) * kstep;
            const char* a2 = last ? nA : cA + (size_t)(t + 2) * kstep; const char* b2 = last ? nB : cB + (size_t)(t + 2) * kstep;
            const char* a3 = a2 + kstep; const char* b3 = b2 + kstep;
            if (last && has_next) S.a_ready(nxt);
            if constexpr (SP2) {
            PG8_LDB(B0, 0, 0); PG8_LDB(B1, 0, 1); PG8_SCHED; PG8_LDA(At, 0, 0); PG8_STAGE(PG8_SA(1, 1), a1 + hstep, voffA);
            PG8_WAIT_V(8); PG8_WAIT_L(0); PG8_BAR; PG8_MMA(0, 0, At, B0); PG8_MMA(0, 1, At, B1); PG8_BAR; PG8_SCHED;
            PG8_LDA(At, 0, 1); PG8_STAGE(PG8_SB(0, 0), b2, voffB); PG8_STAGE(PG8_SB(0, 1), b2 + hstep, voffB); PG8_STAGE(PG8_SA(0, 0), a2, voffA);
            PG8_WAIT_V(8); PG8_WAIT_L(0); PG8_BAR; PG8_MMA(1, 0, At, B0); PG8_MMA(1, 1, At, B1); PG8_BAR; PG8_SCHED;
            PG8_LDB(B0, 1, 0); PG8_LDB(B1, 1, 1); PG8_SCHED; PG8_LDA(At, 1, 0); PG8_STAGE(PG8_SA(0, 1), a2 + hstep, voffA);
            PG8_WAIT_V(8); PG8_WAIT_L(0); PG8_BAR; PG8_MMA(0, 0, At, B0); PG8_MMA(0, 1, At, B1); PG8_BAR; PG8_SCHED;
            PG8_LDA(At, 1, 1); PG8_STAGE(PG8_SB(1, 0), b3, voffB); PG8_STAGE(PG8_SB(1, 1), b3 + hstep, voffB); PG8_STAGE(PG8_SA(1, 0), a3, voffA);
            PG8_WAIT_V(8); PG8_WAIT_L(0); PG8_BAR; PG8_MMA(1, 0, At, B0); PG8_MMA(1, 1, At, B1); PG8_BAR; PG8_SCHED;
            } else {
            PG8_LDB(B0, 0, 0); PG8_SCHED; PG8_LDA(At, 0, 0); PG8_STAGE(PG8_SA(1, 1), a1 + hstep, voffA);
            PG8_WAIT_L(8); PG8_BAR; PG8_WAIT_L(0); PG8_MMA(0, 0, At, B0); PG8_BAR; PG8_SCHED;
            PG8_LDB(B1, 0, 1); PG8_STAGE(PG8_SB(0, 0), b2, voffB);
            PG8_BAR; PG8_WAIT_L(0); PG8_MMA(0, 1, At, B1); PG8_BAR;
            PG8_LDA(At, 0, 1); PG8_STAGE(PG8_SA(0, 0), a2, voffA);
            PG8_BAR; PG8_WAIT_L(0); PG8_MMA(1, 0, At, B0); PG8_BAR; PG8_SCHED;
            PG8_STAGE(PG8_SB(0, 1), b2 + hstep, voffB);
            PG8_WAIT_V(6); PG8_BAR; PG8_MMA(1, 1, At, B1); PG8_BAR;
            PG8_LDB(B0, 1, 0); PG8_SCHED; PG8_LDA(At, 1, 0); PG8_STAGE(PG8_SA(0, 1), a2 + hstep, voffA);
            PG8_WAIT_L(8); PG8_BAR; PG8_WAIT_L(0); PG8_MMA(0, 0, At, B0); PG8_BAR; PG8_SCHED;
            PG8_LDB(B1, 1, 1); PG8_STAGE(PG8_SB(1, 0), b3, voffB);
            PG8_BAR; PG8_WAIT_L(0); PG8_MMA(0, 1, At, B1); PG8_BAR;
            PG8_LDA(At, 1, 1); PG8_STAGE(PG8_SA(1, 0), a3, voffA);
            PG8_BAR; PG8_WAIT_L(0); PG8_MMA(1, 0, At, B0); PG8_BAR; PG8_SCHED;
            PG8_STAGE(PG8_SB(1, 1), b3 + hstep, voffB);
            PG8_WAIT_V(6); PG8_BAR; PG8_MMA(1, 1, At, B1); PG8_BAR;
            }
        }
        if constexpr (ALIGN_EPI) { if (wr == 0) PG8_BAR; }
        if constexpr (!Epi::AFTER_DRAIN) { E(acc, cur, wr, wc, fr, fq); S.done(cur); }
        if (!has_next) break;
#pragma unroll
        for (int a = 0; a < 2; ++a)
#pragma unroll
            for (int b = 0; b < 2; ++b)
#pragma unroll
                for (int m = 0; m < 4; ++m)
#pragma unroll
                    for (int n = 0; n < 2; ++n) acc[a][b][m][n] = (acc_t){0, 0, 0, 0};
        cur = nxt; cA = nA; cB = nB; ++ui;
        if constexpr (ALIGN_EPI) { if (wr == 1) PG8_BAR; }
    }
    PG8_WAIT_V(0);
    if constexpr (!ALIGN_EPI) { if (wr == 0) PG8_BAR; }
    PG8_BAR;
    if constexpr (Epi::AFTER_DRAIN) { E.fused(acc, cur, wr, wc, fr, fq, lds, wid, lane); S.done(cur); }
#undef PG8_SA
#undef PG8_SB
#undef PG8_STAGE
#undef PG8_LDA
#undef PG8_LDB
#undef PG8_MMA
#undef PG8_WAIT_V
#undef PG8_WAIT_L
#undef PG8_BAR
#undef PG8_SCHED
}
}
constexpr int BATCH = 4, SEQ = 4096, D = 2048, M = BATCH * SEQ, DFF = 5632, DIN = 4096, DG = 1024;
constexpr float EPS = 1e-6f;
constexpr int NWAVES = 8;
#ifndef PG8_ALIGN
#define PG8_ALIGN true
#endif
#ifndef PG8_SP2
#define PG8_SP2 true
#endif
#ifndef MK_MODE
#define MK_MODE 0
#endif
#ifndef REP_PRO
#define REP_PRO 1
#endif
#ifndef REP_NORM
#define REP_NORM 1
#endif
#ifndef REP_MIXA
#define REP_MIXA 1
#endif
#ifndef REP_MIXB
#define REP_MIXB 1
#endif
#ifndef REP_GU
#define REP_GU 1
#endif
#ifndef REP_DOWN
#define REP_DOWN 1
#endif
#ifndef REP_WIN
#define REP_WIN 1
#endif
#ifndef REP_WOUT
#define REP_WOUT 1
#endif
#ifndef W8_FROM
#define W8_FROM 8
#endif
#ifndef XBF16
#define XBF16 1
#endif
#if defined(DUMMY_N) && DUMMY_N > 0
constexpr int NPH = 24;
#else
constexpr int NPH = 23;
#endif

constexpr size_t MiB = 1u << 20;
constexpr size_t WS_CTL = 0, CTL_ZERO_BYTES = (MK_MODE == 0) ? 64 * 1024 : 1 * MiB;
constexpr size_t WS_VPART = 1 * MiB;
constexpr size_t WS_SUMM = 2 * MiB;
constexpr size_t WS_SA = 5 * MiB;
constexpr size_t WS_SW = 6 * MiB;
constexpr size_t WS_LRUW = 4 * MiB;
constexpr size_t SZ_WGU8 = (size_t)2 * DFF * D;
constexpr size_t WS_WGU = 8 * MiB, SZ_WGU = (size_t)2 * DFF * D;
constexpr size_t WS_WD = 184 * MiB, SZ_WD = (size_t)D * DFF;
constexpr size_t WS_WIN = 272 * MiB, SZ_WIN = (size_t)DIN * D;
constexpr int NBF = W8_FROM * 256, N8 = DIN - NBF;
constexpr size_t WS_SWIN = 7 * MiB;
static_assert(N8 == 0 || (N8 % 1024 == 0 && NBF % 1024 == 0), "W_in split: whole rounds of 4 column tiles on each side");
constexpr size_t WS_WOUT = 304 * MiB, SZ_WOUT = (size_t)D * D;
constexpr size_t WS_H = 320 * MiB;
constexpr size_t WS_Y = 384 * MiB;
constexpr size_t WS_ACT = 448 * MiB;
constexpr size_t WS_DELTA = 624 * MiB;
constexpr size_t WS_XB = 96 * MiB;
constexpr size_t WS_END = 688 * MiB;
static_assert(WS_WGU + 4 * SZ_WGU * 2 <= WS_WD && WS_WD + 4 * SZ_WD * 2 <= WS_WIN && WS_WIN + 2 * SZ_WIN * 2 <= WS_WOUT && WS_WOUT + 2 * SZ_WOUT * 2 <= WS_H, "ws map (weights)");
static_assert(WS_H + (size_t)M * D * 2 <= WS_Y && WS_Y + (size_t)M * D * 2 <= WS_ACT && WS_ACT + (size_t)M * DFF * 2 <= WS_DELTA && WS_DELTA + (size_t)M * D * 2 <= WS_END && WS_WGU + 4 * SZ_WGU8 <= WS_XB && WS_XB + (size_t)M * D * 2 <= WS_WD, "ws map (activations)");
constexpr int CW_BAR = 4096;
constexpr int RING_BYTES = 131072;
constexpr int LDSCTL_OFF = RING_BYTES, MISC_OFF = 147456 - 128;
constexpr int LDS_BYTES = 147456;
constexpr int SCALE_TAB_OFF = LDSCTL_OFF + 1024;
static_assert(SCALE_TAB_OFF + 12 * 1024 <= MISC_OFF && MISC_OFF + 128 <= LDS_BYTES, "LDS map");

#define LAS __attribute__((address_space(3)))
typedef unsigned short bf16_t;
typedef float f32x4 __attribute__((ext_vector_type(4)));
typedef float f32x2 __attribute__((ext_vector_type(2)));
typedef unsigned u32x4 __attribute__((ext_vector_type(4)));
typedef unsigned u32x2 __attribute__((ext_vector_type(2)));
typedef short bf16x8 __attribute__((ext_vector_type(8)));
typedef short s16x4 __attribute__((ext_vector_type(4)));
#define LDS_WAIT() asm volatile("s_waitcnt lgkmcnt(0)" ::: "memory")
__device__ __forceinline__ unsigned pk2(float lo, float hi) { return pg8::cvt_pk_bf16(lo, hi); }
__device__ __forceinline__ float bflo(unsigned w) { return __uint_as_float(w << 16); }
__device__ __forceinline__ float bfhi(unsigned w) { return __uint_as_float(w & 0xffff0000u); }
__device__ __forceinline__ float wave_sum(float v) {
#pragma unroll
    for (int o = 1; o < 64; o <<= 1) v += __shfl_xor(v, o);
    return v;
}
__device__ __forceinline__ float wave_max(float v) {
#pragma unroll
    for (int o = 1; o < 64; o <<= 1) v = fmaxf(v, __shfl_xor(v, o));
    return v;
}
__device__ __forceinline__ unsigned pack_i8x4(f32x4 y, float inv) {
    const int q0 = (int)__builtin_rintf(y[0] * inv), q1 = (int)__builtin_rintf(y[1] * inv), q2 = (int)__builtin_rintf(y[2] * inv), q3 = (int)__builtin_rintf(y[3] * inv);
    return ((unsigned)q0 & 255u) | (((unsigned)q1 & 255u) << 8) | (((unsigned)q2 & 255u) << 16) | ((unsigned)q3 << 24);
}
__device__ __forceinline__ void store_row_q8(const f32x4 (&y)[8], unsigned char* H8, float* SA, int m, int lane) {
    float am = 0.f;
#pragma unroll
    for (int j = 0; j < 8; ++j) am = fmaxf(fmaxf(am, fmaxf(fabsf(y[j][0]), fabsf(y[j][1]))), fmaxf(fabsf(y[j][2]), fabsf(y[j][3])));
    am = wave_max(am);
    const float inv = am > 0.f ? 127.0f / am : 0.f;
    unsigned* o = (unsigned*)(H8 + (size_t)m * D) + lane;
#pragma unroll
    for (int j = 0; j < 8; ++j) o[64 * j] = pack_i8x4(y[j], inv);
    if (lane == 0) SA[m] = am * (1.0f / 127.0f);
}
__device__ __forceinline__ float sigmoid_f(float x) { return __builtin_amdgcn_rcpf(1.0f + __builtin_amdgcn_exp2f(-1.4426950408889634f * x)); }

#define XB_TMO      128
#define XB_XCNT(j)  (256  + 64 * (j))
#define XB_XSUB(j)  (1280 + 64 * (j))
#define XB_XGEN(j)  (2304 + 64 * (j))
#define XB_TOP      3328
#define XB_TOPGEN   3392
#define XCD_BAR_WORDS 3456
#define XB_SPIN_CAP (1u << 18)

__device__ __forceinline__ unsigned xb_ld(unsigned* p)              { return __hip_atomic_load(p, __ATOMIC_RELAXED, __HIP_MEMORY_SCOPE_AGENT); }
__device__ __forceinline__ unsigned xb_add(unsigned* p, unsigned v) { return __hip_atomic_fetch_add(p, v, __ATOMIC_RELAXED, __HIP_MEMORY_SCOPE_AGENT); }
__device__ __forceinline__ unsigned xb_xcc_id() { return (unsigned)__builtin_amdgcn_s_getreg((3 << 11) | 20) & 0xFu; }
#define XB_SPIN(cond, bar) do { unsigned _sp = 0; while (cond) { __builtin_amdgcn_s_sleep(1); \
    if ((++_sp & 255u) == 0u) { if (xb_ld(&(bar)[XB_TMO])) break; if (_sp > XB_SPIN_CAP) { atomicAdd(&(bar)[XB_TMO], 1u); break; } } } } while (0)

struct XcdBarrier {
    unsigned* bar; unsigned x;
    volatile LAS unsigned* st;
};

__device__ __forceinline__ XcdBarrier xcd_barrier_post(unsigned* bar, volatile LAS unsigned* st) {
    XcdBarrier b; b.bar = bar; b.x = xb_xcc_id(); b.st = st;
    if (threadIdx.x == 0) (void)xb_add(&bar[XB_XCNT(b.x)], 1u);
    return b;
}
__device__ __forceinline__ void xcd_barrier_complete(unsigned* bar, unsigned x, unsigned& nloc, unsigned& nx) {
    const unsigned G = gridDim.x * gridDim.y * gridDim.z;
    unsigned sum, cnt, mine, sp = 0u;
    for (;;) {
        sum = 0u; cnt = 0u; mine = 0u;
#pragma unroll
        for (unsigned j = 0; j < 16; ++j) { const unsigned c = xb_ld(&bar[XB_XCNT(j)]); sum += c; cnt += (c > 0u) ? 1u : 0u; mine = (j == x) ? c : mine; }
        if (sum == G) break;
        __builtin_amdgcn_s_sleep(1);
        if ((++sp & 255u) == 0u) { if (xb_ld(&bar[XB_TMO])) break; if (sp > XB_SPIN_CAP) { atomicAdd(&bar[XB_TMO], 1u); break; } }
    }
    nloc = mine > 0u ? mine : 1u; nx = cnt > 0u ? cnt : 1u;
}

__device__ __forceinline__ void xcd_barrier(const XcdBarrier& b) {
    asm volatile("s_waitcnt vmcnt(0)" ::: "memory");
    __syncthreads();
    if (threadIdx.x == 0) {
        unsigned* bar = b.bar;
        __builtin_amdgcn_s_waitcnt(0);
        unsigned nloc = b.st[0], nx = b.st[1];
        if (nloc == 0u) { xcd_barrier_complete(bar, b.x, nloc, nx); b.st[0] = nloc; b.st[1] = nx; }
        const unsigned old = xb_add(&bar[XB_XSUB(b.x)], 1u);
        const unsigned gen = old / nloc;
        if (old + 1u == (gen + 1u) * nloc) {
            __builtin_amdgcn_fence(__ATOMIC_RELEASE, "agent");
            asm volatile("s_waitcnt vmcnt(0)" ::: "memory");
            const unsigned og = xb_add(&bar[XB_TOP], 1u);
            const unsigned tg = og / nx;
            if (og + 1u == (tg + 1u) * nx) xb_add(&bar[XB_TOPGEN], 1u);
            else XB_SPIN(xb_ld(&bar[XB_TOPGEN]) == tg, bar);
            __builtin_amdgcn_fence(__ATOMIC_ACQUIRE, "agent");
            xb_add(&bar[XB_XGEN(b.x)], 1u);
            asm volatile("s_waitcnt vmcnt(0)" ::: "memory");
        } else {
            XB_SPIN(xb_ld(&bar[XB_XGEN(b.x)]) == gen, bar);
            __builtin_amdgcn_fence(__ATOMIC_ACQUIRE, "agent");
            asm volatile("s_waitcnt vmcnt(0)" ::: "memory");
        }
    }
    __syncthreads();
}

__device__ __forceinline__ void tr_item(const float* W, int K, int N, int ldn, bf16_t* WT, int mode, LAS unsigned* scr, int item, int lane) {
    const int nblk = N >> 6, kb = item / nblk, nb = item - kb * nblk, k0 = kb << 6, n0 = nb << 6;
    const int kr = lane >> 4, c4 = lane & 15;
    f32x4 va[8], vb[8];
#pragma unroll
    for (int i = 0; i < 8; ++i) { const float* p = W + (size_t)(k0 + 8 * i + 2 * kr) * ldn + n0 + 4 * c4; va[i] = *(const f32x4*)p; vb[i] = *(const f32x4*)(p + ldn); }
#pragma unroll
    for (int i = 0; i < 8; ++i)
#pragma unroll
        for (int e = 0; e < 4; ++e) scr[(4 * i + kr) * 65 + 4 * c4 + e] = pk2(va[i][e], vb[i][e]);
    LDS_WAIT();
    const int nr = lane >> 3, c = lane & 7;
#pragma unroll
    for (int pp = 0; pp < 8; ++pp) { const int n = 8 * pp + nr; u32x4 o;
        o.x = scr[(4 * c + 0) * 65 + n]; o.y = scr[(4 * c + 1) * 65 + n]; o.z = scr[(4 * c + 2) * 65 + n]; o.w = scr[(4 * c + 3) * 65 + n];
        const int ng = n0 + n; const int orow = (mode == 0) ? ng : (((ng >> 7) << 8) + (ng & 127) + (mode == 2 ? 128 : 0));
        *(u32x4*)(WT + (size_t)orow * K + k0 + 8 * c) = o; }
    LDS_WAIT();
}
__device__ __forceinline__ void strip_q8(const float* W, int ldw, unsigned char* WT8, int mode, float* sw, LAS unsigned char* lds, int sc, int tid, int lane, int wave) {
    constexpr int PITCH = 4112;
    LAS float* CM = (LAS float*)(lds + 133120);
    const int n0 = 32 * sc, kr = lane >> 3, c4 = lane & 7, kbase = 256 * wave;
    __syncthreads();
    f32x4 mx = {0.f, 0.f, 0.f, 0.f};
#pragma unroll
    for (int hb = 0; hb < 2; ++hb) { f32x4 ra[8], rb[8];
#pragma unroll
        for (int i = 0; i < 8; ++i) { const float* p = W + (size_t)(kbase + 128 * hb + 16 * i + 2 * kr) * ldw + n0 + 4 * c4; ra[i] = *(const f32x4*)p; rb[i] = *(const f32x4*)(p + ldw); }
#pragma unroll
        for (int i = 0; i < 8; ++i) { const int k = kbase + 128 * hb + 16 * i + 2 * kr;
#pragma unroll
            for (int e = 0; e < 4; ++e) { mx[e] = fmaxf(mx[e], fmaxf(fabsf(ra[i][e]), fabsf(rb[i][e]))); *(LAS unsigned*)(lds + (4 * c4 + e) * PITCH + 2 * k) = pk2(ra[i][e], rb[i][e]); } } }
#pragma unroll
    for (int e = 0; e < 4; ++e) { mx[e] = fmaxf(mx[e], __shfl_xor(mx[e], 8)); mx[e] = fmaxf(mx[e], __shfl_xor(mx[e], 16)); mx[e] = fmaxf(mx[e], __shfl_xor(mx[e], 32)); }
    if (kr == 0) *(LAS f32x4*)(CM + wave * 32 + 4 * c4) = mx;
    __syncthreads();
    if (tid < 32) { float m = CM[tid];
#pragma unroll
        for (int w = 1; w < 8; ++w) m = fmaxf(m, CM[w * 32 + tid]);
        CM[256 + tid] = m; const int ng = n0 + tid; sw[mode == 0 ? ng : ((ng >> 7) << 8) + (ng & 127) + (mode == 2 ? 128 : 0)] = m * (1.0f / 127.0f); }
    __syncthreads();
    const int n = tid >> 4, kc = tid & 15; const float cmx = CM[256 + n], inv = cmx > 0.f ? 127.0f / cmx : 0.f;
    const int ng = n0 + n; unsigned char* orow = WT8 + (size_t)(mode == 0 ? ng : ((ng >> 7) << 8) + (ng & 127) + (mode == 2 ? 128 : 0)) * D;
#pragma unroll
    for (int q = 0; q < 8; ++q) { const int k = 16 * (kc + 16 * q); const u32x4 a = *(const LAS u32x4*)(lds + n * PITCH + 2 * k), b = *(const LAS u32x4*)(lds + n * PITCH + 2 * k + 16);
        const unsigned wv[8] = {a.x, a.y, a.z, a.w, b.x, b.y, b.z, b.w}; u32x4 o;
#pragma unroll
        for (int g = 0; g < 4; ++g) { const float f0 = fminf(fmaxf(__builtin_rintf(bflo(wv[2 * g]) * inv), -127.f), 127.f), f1 = fminf(fmaxf(__builtin_rintf(bfhi(wv[2 * g]) * inv), -127.f), 127.f),
                f2 = fminf(fmaxf(__builtin_rintf(bflo(wv[2 * g + 1]) * inv), -127.f), 127.f), f3 = fminf(fmaxf(__builtin_rintf(bfhi(wv[2 * g + 1]) * inv), -127.f), 127.f);
            o[g] = ((unsigned)(int)f0 & 255u) | (((unsigned)(int)f1 & 255u) << 8) | (((unsigned)(int)f2 & 255u) << 16) | ((unsigned)(int)f3 << 24); }
        *(u32x4*)(orow + k) = o; }
}
template <int OUT  >
__device__ __forceinline__ void norm_rows(const float* X, const float* gain, void* out, float* SA, int gw, int NGW, int lane) {
    f32x4 gv[8];
#pragma unroll
    for (int j = 0; j < 8; ++j) gv[j] = ((const f32x4*)gain)[lane + 64 * j];
    for (int m = gw; m < M; m += NGW) {
        const f32x4* xr = (const f32x4*)(X + (size_t)m * D) + lane; f32x4 v[8]; float s = 0.f;
#pragma unroll
        for (int j = 0; j < 8; ++j) { v[j] = xr[64 * j]; s += (v[j][0] * v[j][0] + v[j][1] * v[j][1]) + (v[j][2] * v[j][2] + v[j][3] * v[j][3]); }
        const float rstd = 1.0f / sqrtf(wave_sum(s) * (1.0f / D) + EPS);
        if (OUT == 1) { f32x4* o = (f32x4*)((float*)out + (size_t)m * D) + lane;
#pragma unroll
            for (int j = 0; j < 8; ++j) o[64 * j] = (v[j] * rstd) * gv[j];
        } else if (OUT == 2) { f32x4 y[8];
#pragma unroll
            for (int j = 0; j < 8; ++j) y[j] = (v[j] * rstd) * gv[j];
            store_row_q8(y, (unsigned char*)out, SA, m, lane);
        } else { u32x2* o = (u32x2*)((bf16_t*)out + (size_t)m * D) + lane;
#pragma unroll
            for (int j = 0; j < 8; ++j) { const f32x4 y = (v[j] * rstd) * gv[j]; u32x2 w; w.x = pk2(y[0], y[1]); w.y = pk2(y[2], y[3]); o[64 * j] = w; } }
    }
}

template <bool FINAL, bool XB16>
__device__ __forceinline__ void resnorm_rows(const float* base, const bf16_t* baseb, bool base16, const bf16_t* delta, float scale, const float* gain, float* X, bf16_t* XBo, bf16_t* Hout, int q8, unsigned char* H8out, float* SA, int gw, int NGW, int lane) {
    f32x4 gv[8];
#pragma unroll
    for (int j = 0; j < 8; ++j) gv[j] = ((const f32x4*)gain)[lane + 64 * j];
    for (int m = gw; m < M; m += NGW) {
        const u32x2* dr = (const u32x2*)(delta + (size_t)m * D) + lane; f32x4 v[8]; u32x2 dv[8]; float s = 0.f;
        if (XB16 && base16) { const u32x2* xr = (const u32x2*)(baseb + (size_t)m * D) + lane;
#pragma unroll
            for (int j = 0; j < 8; ++j) { const u32x2 w = xr[64 * j]; dv[j] = dr[64 * j]; v[j] = (f32x4){bflo(w.x), bfhi(w.x), bflo(w.y), bfhi(w.y)}; }
        } else { const f32x4* xr = (const f32x4*)(base + (size_t)m * D) + lane;
#pragma unroll
            for (int j = 0; j < 8; ++j) { v[j] = xr[64 * j]; dv[j] = dr[64 * j]; } }
#pragma unroll
        for (int j = 0; j < 8; ++j) { v[j][0] += scale * bflo(dv[j].x); v[j][1] += scale * bfhi(dv[j].x); v[j][2] += scale * bflo(dv[j].y); v[j][3] += scale * bfhi(dv[j].y);
            s += (v[j][0] * v[j][0] + v[j][1] * v[j][1]) + (v[j][2] * v[j][2] + v[j][3] * v[j][3]); }
        const float rstd = 1.0f / sqrtf(wave_sum(s) * (1.0f / D) + EPS);
        if (FINAL) { f32x4* xo = (f32x4*)(X + (size_t)m * D) + lane;
#pragma unroll
            for (int j = 0; j < 8; ++j) xo[64 * j] = (v[j] * rstd) * gv[j];
        } else { u32x2* o = (u32x2*)(Hout + (size_t)m * D) + lane;
            if (XB16) { u32x2* xo = (u32x2*)(XBo + (size_t)m * D) + lane;
#pragma unroll
                for (int j = 0; j < 8; ++j) { u32x2 w; w.x = pk2(v[j][0], v[j][1]); w.y = pk2(v[j][2], v[j][3]); xo[64 * j] = w; }
            } else { f32x4* xo = (f32x4*)(X + (size_t)m * D) + lane;
#pragma unroll
                for (int j = 0; j < 8; ++j) xo[64 * j] = v[j]; }
            f32x4 y[8];
#pragma unroll
            for (int j = 0; j < 8; ++j) y[j] = (v[j] * rstd) * gv[j];
            if (q8 != 1) {
#pragma unroll
                for (int j = 0; j < 8; ++j) { u32x2 w; w.x = pk2(y[j][0], y[j][1]); w.y = pk2(y[j][2], y[j][3]); o[64 * j] = w; } }
            if (q8 != 0) store_row_q8(y, H8out, SA, m, lane); }
    }
}


__device__ __forceinline__ void gmlp_phase(LAS unsigned char* lds, int l, const bf16_t* Z, bf16_t* Y, const float* vpart,
                                           const float* w_s, const float* b_s, const float* v_gain, int tid, int lane, int wave, int bx, int G) {
    constexpr int NU = BATCH * 32 * 8;
    if (bx >= NU) return;
    const int h = bx & 7;
    LAS unsigned char* VS = lds; LAS float* RS = (LAS float*)(lds + 128 * 272);
    const int fr = lane & 15, kg = lane >> 4, q = 16 * wave + fr;
    const int nks = (wave < 4) ? 2 : 4;
    f32x4 wraw[4][2];
    { const float* wrow = w_s + ((size_t)(l * 8 + h) * 128 + q) * 128 + 8 * kg;
#pragma unroll
      for (int ks = 0; ks < 4; ++ks) { wraw[ks][0] = *(const f32x4*)(wrow + 32 * ks); wraw[ks][1] = *(const f32x4*)(wrow + 32 * ks + 4); } }
    const float bias = b_s[(l * 8 + h) * 128 + q];
    f32x4 gn[8];
    { const float* grow = v_gain + l * DG + 128 * h + 4 * kg;
#pragma unroll
      for (int dt = 0; dt < 8; ++dt) gn[dt] = *(const f32x4*)(grow + 16 * dt); }
    const LAS unsigned char* trb = VS + (8 * kg + (fr >> 2)) * 272 + 8 * (lane & 3);
    const int vrow = tid >> 4, vch = tid & 15;
    f32x4 vp[4]; u32x4 vv[4]; u32x2 uu[8];
#define GMLP_LOAD(unit) do { const int m0_ = ((unit) >> 8) * SEQ + (((unit) >> 3) & 31) * 128; \
        { const f32x4* p_ = (const f32x4*)(vpart + (size_t)(m0_ + (tid & 127)) * 16); vp[0] = p_[0]; vp[1] = p_[1]; vp[2] = p_[2]; vp[3] = p_[3]; } \
        _Pragma("unroll") for (int pass = 0; pass < 4; ++pass) vv[pass] = *(const u32x4*)(Z + (size_t)(m0_ + vrow + 32 * pass) * DIN + DG + 128 * h + 8 * vch); \
        { const bf16_t* ur_ = Z + (size_t)(m0_ + q) * DIN + 128 * h + 4 * kg; _Pragma("unroll") for (int dt = 0; dt < 8; ++dt) uu[dt] = *(const u32x2*)(ur_ + 16 * dt); } } while (0)
    GMLP_LOAD(bx);
    for (int u = bx; u < NU; u += G) {
        const int m0 = (u >> 8) * SEQ + ((u >> 3) & 31) * 128;
        __syncthreads();
        if (tid < 128) { const float s = (((vp[0][0] + vp[0][1]) + (vp[0][2] + vp[0][3])) + ((vp[1][0] + vp[1][1]) + (vp[1][2] + vp[1][3]))) + (((vp[2][0] + vp[2][1]) + (vp[2][2] + vp[2][3])) + ((vp[3][0] + vp[3][1]) + (vp[3][2] + vp[3][3])));
            RS[tid] = 1.0f / sqrtf(s * (1.0f / DG) + EPS); }
#pragma unroll
        for (int pass = 0; pass < 4; ++pass) *(LAS u32x4*)(VS + (vrow + 32 * pass) * 272 + 16 * vch) = vv[pass];
        u32x2 uc[8];
#pragma unroll
        for (int dt = 0; dt < 8; ++dt) uc[dt] = uu[dt];
        { const int un = (u + G < NU) ? u + G : u; GMLP_LOAD(un); }
        __syncthreads();
        bf16x8 wf[4];
#pragma unroll
        for (int ks = 0; ks < 4; ++ks) {
            if (ks < nks) { const int p0 = 32 * ks + 8 * kg; const f32x4 r0 = *(const LAS f32x4*)(RS + p0), r1 = *(const LAS f32x4*)(RS + p0 + 4); const f32x4 w0 = wraw[ks][0] * r0, w1 = wraw[ks][1] * r1;
                u32x4 t; t.x = pk2(w0[0], w0[1]); t.y = pk2(w0[2], w0[3]); t.z = pk2(w1[0], w1[1]); t.w = pk2(w1[2], w1[3]); wf[ks] = __builtin_bit_cast(bf16x8, t);
            } else wf[ks] = (bf16x8){0, 0, 0, 0, 0, 0, 0, 0}; }
        bf16_t* yrow = Y + (size_t)(m0 + q) * D + 128 * h + 4 * kg;
#pragma unroll
        for (int dt = 0; dt < 8; ++dt) { f32x4 acc = {0.f, 0.f, 0.f, 0.f};
#pragma unroll
            for (int ks = 0; ks < 4; ++ks) if (ks < nks) {
                const LAS unsigned char* p = trb + (32 * ks) * 272 + 32 * dt;
                const s16x4 t0 = __builtin_amdgcn_ds_read_tr16_b64_v4i16((LAS s16x4*)p), t1 = __builtin_amdgcn_ds_read_tr16_b64_v4i16((LAS s16x4*)(p + 4 * 272));
                const bf16x8 vf = __builtin_shufflevector(t0, t1, 0, 1, 2, 3, 4, 5, 6, 7);
                acc = __builtin_amdgcn_mfma_f32_16x16x32_bf16(vf, wf[ks], acc, 0, 0, 0); }
            const float y0 = bflo(uc[dt].x) * (gn[dt][0] * acc[0] + bias), y1 = bfhi(uc[dt].x) * (gn[dt][1] * acc[1] + bias), y2 = bflo(uc[dt].y) * (gn[dt][2] * acc[2] + bias), y3 = bfhi(uc[dt].y) * (gn[dt][3] * acc[3] + bias);
            u32x2 w; w.x = pk2(y0, y1); w.y = pk2(y2, y3); *(u32x2*)(yrow + 16 * dt) = w; }
    }
#undef GMLP_LOAD
    __syncthreads();
}

template <int PASS>
__device__ __forceinline__ void lru_phase(LAS unsigned char* lds, int l, const bf16_t* Z, bf16_t* Y, float* summ, const bf16_t* lruw,
                                          const float* conv_w, const float* conv_b, const float* b_a, const float* b_x, const float* lam, int tid, int lane, int wave, int bx, int G) {
    constexpr int NU = BATCH * 64 * 8;
    if (bx >= NU) return;
    const int j = bx & 7, ch0 = 128 * j;
    LAS float* XC = (LAS float*)lds;
    LAS float* AS = (LAS float*)(lds + 33792);
    LAS unsigned char* XB = lds + 67584;
    LAS float* SEGS = (LAS float*)(lds + 84992);
    LAS float* PART = (LAS float*)(lds + 89088);
    const int chn = tid & 127, seg = tid >> 7;
    const int fr = lane & 15, kg = lane >> 4, chl = 16 * wave + 4 * kg;
    const int ct = tid >> 4, c8 = tid & 15;
    bf16x8 wa[4], wx[4];
    { const bf16_t* wbase = lruw + ((size_t)((l * 2 + 0) * 8 + j) * 128 + 16 * wave + fr) * 128 + 8 * kg;
#pragma unroll
      for (int ks = 0; ks < 4; ++ks) { wa[ks] = *(const bf16x8*)(wbase + 32 * ks); wx[ks] = *(const bf16x8*)(wbase + 8 * 128 * 128 + 32 * ks); } }
    const f32x4 bav = *(const f32x4*)(b_a + l * DG + ch0 + chl), bxv = *(const f32x4*)(b_x + l * DG + ch0 + chl);
    f32x4 spv; { const f32x4 lmv = *(const f32x4*)(lam + l * DG + ch0 + chl);
#pragma unroll
      for (int e = 0; e < 4; ++e) spv[e] = -8.0f * 1.4426950408889634f * log1pf(expf(-lmv[e])); }
    f32x4 cw[4][2], cb[2];
    { const float* cbp = conv_b + l * DG + ch0 + 8 * c8; cb[0] = *(const f32x4*)cbp; cb[1] = *(const f32x4*)(cbp + 4);
#pragma unroll
      for (int i = 0; i < 4; ++i) { const float* wp = conv_w + (size_t)(l * 4 + i) * DG + ch0 + 8 * c8; cw[i][0] = *(const f32x4*)wp; cw[i][1] = *(const f32x4*)(wp + 4); } }
    u32x4 xr[2][4]; u32x4 gg[2]; f32x2 sv[16];
#define LRU_LOAD(unit) do { const int c_ = ((unit) >> 3) & 63, b_ = (unit) >> 9; \
        _Pragma("unroll") for (int it0 = 0; it0 < 2; ++it0) _Pragma("unroll") for (int i = 0; i < 4; ++i) { const int tg = c_ * 64 + ct + 32 * it0 - 3 + i, tgc = tg < 0 ? 0 : tg; \
            xr[it0][i] = *(const u32x4*)(Z + (size_t)(b_ * SEQ + tgc) * DIN + 3 * DG + ch0 + 8 * c8); } \
        if (PASS == 1) { _Pragma("unroll") for (int it0 = 0; it0 < 2; ++it0) gg[it0] = *(const u32x4*)(Z + (size_t)(b_ * SEQ + c_ * 64 + ct + 32 * it0) * DIN + 2 * DG + ch0 + 8 * c8); \
            const float* sp_ = summ + ((size_t)(b_ * 64) * 1024 + ch0 + chn) * 2; \
            _Pragma("unroll") for (int k = 0; k < 16; ++k) { const int kk = seg * 16 + k, kc = kk < c_ ? kk : 0; sv[k] = *(const f32x2*)(sp_ + (size_t)kc * 2048); } } } while (0)
    LRU_LOAD(bx);
    for (int u = bx; u < NU; u += G) {
        const int c = (u >> 3) & 63, b = u >> 9, m0 = b * SEQ + c * 64;
        __syncthreads();
        if (PASS == 1) { float cP = 1.f, cH = 0.f;
#pragma unroll
            for (int k = 0; k < 16; ++k) { const bool on = (seg * 16 + k) < c; const float pa = on ? sv[k][0] : 1.f, ph = on ? sv[k][1] : 0.f; cH = pa * cH + ph; cP *= pa; }
            PART[(seg * 128 + chn) * 2] = cP; PART[(seg * 128 + chn) * 2 + 1] = cH; }
#pragma unroll
        for (int it0 = 0; it0 < 2; ++it0) { const int t = ct + 32 * it0; f32x4 a0 = cb[0], a1 = cb[1];
#pragma unroll
            for (int i = 0; i < 4; ++i) { u32x4 x = xr[it0][i]; if (c * 64 + t - 3 + i < 0) x = (u32x4){0u, 0u, 0u, 0u};
                a0[0] += cw[i][0][0] * bflo(x.x); a0[1] += cw[i][0][1] * bfhi(x.x); a0[2] += cw[i][0][2] * bflo(x.y); a0[3] += cw[i][0][3] * bfhi(x.y);
                a1[0] += cw[i][1][0] * bflo(x.z); a1[1] += cw[i][1][1] * bfhi(x.z); a1[2] += cw[i][1][2] * bflo(x.w); a1[3] += cw[i][1][3] * bfhi(x.w); }
            *(LAS f32x4*)(XC + t * 132 + 8 * c8) = a0; *(LAS f32x4*)(XC + t * 132 + 8 * c8 + 4) = a1;
            u32x4 pw; pw.x = pk2(a0[0], a0[1]); pw.y = pk2(a0[2], a0[3]); pw.z = pk2(a1[0], a1[1]); pw.w = pk2(a1[2], a1[3]);
            *(LAS u32x4*)(XB + t * 272 + 16 * c8) = pw; }
        u32x4 gc[2]; if (PASS == 1) { gc[0] = gg[0]; gc[1] = gg[1]; }
        { const int un = (u + G < NU) ? u + G : u; LRU_LOAD(un); }
        __syncthreads();
#pragma unroll
        for (int tt = 0; tt < 4; ++tt) { f32x4 accA = {0.f, 0.f, 0.f, 0.f}, accX = {0.f, 0.f, 0.f, 0.f};
#pragma unroll
            for (int ks = 0; ks < 4; ++ks) { const bf16x8 xf = *(const LAS bf16x8*)(XB + (16 * tt + fr) * 272 + (32 * ks + 8 * kg) * 2);
                accA = __builtin_amdgcn_mfma_f32_16x16x32_bf16(wa[ks], xf, accA, 0, 0, 0); accX = __builtin_amdgcn_mfma_f32_16x16x32_bf16(wx[ks], xf, accX, 0, 0, 0); }
            const int t = 16 * tt + fr; const f32x4 xcv = *(const LAS f32x4*)(XC + t * 132 + chl); f32x4 av, gv;
#pragma unroll
            for (int e = 0; e < 4; ++e) { const float r = sigmoid_f(accA[e] + bav[e]), ig = sigmoid_f(accX[e] + bxv[e]);
                const float l2a = r * spv[e];
                const float a = __builtin_amdgcn_exp2f(l2a);
                const float y = l2a * (2.0f * 0.6931471805599453f);
                float p = 1.0f + y * (1.0f / 7.0f); p = 1.0f + (y * (1.0f / 6.0f)) * p; p = 1.0f + (y * 0.2f) * p; p = 1.0f + (y * 0.25f) * p; p = 1.0f + (y * (1.0f / 3.0f)) * p; p = 1.0f + (y * 0.5f) * p;
                const float em = (y > -0.5f) ? -(y * p) : (1.0f - a * a);
                av[e] = a; gv[e] = __builtin_amdgcn_sqrtf(em) * (ig * xcv[e]); }
            *(LAS f32x4*)(AS + t * 132 + chl) = av; *(LAS f32x4*)(XC + t * 132 + chl) = gv; }
        __syncthreads();
        float P = 1.f, H = 0.f;
#pragma unroll
        for (int k = 0; k < 16; ++k) { const int t = 16 * seg + k; const float a = AS[t * 132 + chn], g = XC[t * 132 + chn]; H = a * H + g; P *= a; }
        SEGS[(seg * 128 + chn) * 2] = P; SEGS[(seg * 128 + chn) * 2 + 1] = H;
        __syncthreads();
        if (PASS == 0) {
            if (tid < 128) { float p = 1.f, hh = 0.f;
#pragma unroll
                for (int s = 0; s < 4; ++s) { const float ps = SEGS[(s * 128 + chn) * 2], hs = SEGS[(s * 128 + chn) * 2 + 1]; hh = ps * hh + hs; p *= ps; }
                *(f32x2*)(summ + ((size_t)(b * 64 + c) * 1024 + ch0 + chn) * 2) = (f32x2){p, hh}; }
        } else {
            float hh = 0.f;
#pragma unroll
            for (int s = 0; s < 4; ++s) hh = PART[(s * 128 + chn) * 2] * hh + PART[(s * 128 + chn) * 2 + 1];
#pragma unroll
            for (int s = 0; s < 3; ++s) if (s < seg) hh = SEGS[(s * 128 + chn) * 2] * hh + SEGS[(s * 128 + chn) * 2 + 1];
#pragma unroll
            for (int k = 0; k < 16; ++k) { const int t = 16 * seg + k; const float a = AS[t * 132 + chn], g = XC[t * 132 + chn]; hh = a * hh + g; XC[t * 132 + chn] = hh; }
            __syncthreads();
#pragma unroll
            for (int it0 = 0; it0 < 2; ++it0) { const int t = ct + 32 * it0;
                const f32x4 h0 = *(const LAS f32x4*)(XC + t * 132 + 8 * c8), h1 = *(const LAS f32x4*)(XC + t * 132 + 8 * c8 + 4);
                const u32x4 g4 = gc[it0];
                u32x4 w; w.x = pk2(h0[0] * bflo(g4.x), h0[1] * bfhi(g4.x)); w.y = pk2(h0[2] * bflo(g4.y), h0[3] * bfhi(g4.y));
                w.z = pk2(h1[0] * bflo(g4.z), h1[1] * bfhi(g4.z)); w.w = pk2(h1[2] * bflo(g4.w), h1[3] * bfhi(g4.w));
                *(u32x4*)(Y + (size_t)(m0 + t) * D + DG + ch0 + 8 * c8) = w; }
        }
    }
#undef LRU_LOAD
    __syncthreads();
}

struct Args { const float* in[23]; float* out; unsigned char* ws; int ph_lo, ph_hi, li, pad; };
typedef const Args __attribute__((address_space(4))) CArgs;
#define GETARGS() CArgs* ap = (CArgs*)__builtin_amdgcn_kernarg_segment_ptr(); asm volatile("" : "+s"(ap))
__global__ void __launch_bounds__(NWAVES * 64, 2) mk_fwd(Args args_unused) {
    extern __shared__ __attribute__((aligned(16))) unsigned char lds_raw[];
    LAS unsigned char* lds = (LAS unsigned char*)lds_raw;
    for (int u = threadIdx.x; u < (LDS_BYTES - LDSCTL_OFF) / 4; u += NWAVES * 64) ((LAS unsigned*)(lds + LDSCTL_OFF))[u] = 0u;
    __syncthreads();
    int lo, hi;
    { GETARGS(); lo = ap->ph_lo; hi = ap->ph_hi; (void)xcd_barrier_post((unsigned*)(ap->ws + WS_CTL) + CW_BAR + ap->li * XCD_BAR_WORDS, (volatile LAS unsigned*)(lds + MISC_OFF) + 8); }
    int ph = 0;
#define PH_ON (lo <= ph && ph < hi)
#define PH_END do { if (lo <= ph && ph + 1 < hi) { GETARGS(); XcdBarrier bb; bb.bar = (unsigned*)(ap->ws + WS_CTL) + CW_BAR + ap->li * XCD_BAR_WORDS; bb.x = xb_xcc_id(); bb.st = (volatile LAS unsigned*)(lds + MISC_OFF) + 8; xcd_barrier(bb); } ++ph; } while (0)
#define GEOM() int tid = threadIdx.x; asm volatile("" : "+v"(tid)); const int lane = tid & 63, wave = __builtin_amdgcn_readfirstlane(tid >> 6); (void)lane; const int G = gridDim.x, bx = blockIdx.x; const int vcu = (G % 8 == 0) ? (bx % 8) * (G / 8) + bx / 8 : bx; const int gw = vcu * NWAVES + wave, NGW = G * NWAVES; (void)gw; (void)NGW; (void)vcu

    if (PH_ON) {
        GETARGS(); GEOM(); unsigned char* ws = ap->ws;
        constexpr int I_F = (D / 64) * (DFF / 64), I_IN = (D / 64) * (NBF / 64), I_OUT = (D / 64) * (D / 64);
        constexpr int NSTRIP_F = 8 * (DFF / 32), NSTRIP = NSTRIP_F + 2 * (N8 / 32), NB = 4 * I_F, NC = 2 * I_IN, ND = 2 * I_OUT, NITEM = NB + NC + ND;
        for (int rep = 0; rep < REP_PRO; ++rep) {
        for (int st = bx; st < NSTRIP; st += G) {
            if (st >= NSTRIP_F) { const int r = st - NSTRIP_F, l = r / (N8 / 32), sc = r - l * (N8 / 32);
                strip_q8(ap->in[6] + (size_t)l * D * DIN + NBF, DIN, ws + WS_WIN + (size_t)l * SZ_WIN * 2 + (size_t)NBF * D * 2, 0, (float*)(ws + WS_SWIN) + (size_t)l * N8, lds, sc, tid, lane, wave); continue; }
            const int mat = st / (DFF / 32), sc = st - mat * (DFF / 32), l = mat >> 2, f = (mat >> 1) & 1, up = mat & 1;
            strip_q8((f ? (up ? ap->in[20] : ap->in[19]) : (up ? ap->in[3] : ap->in[2])) + (size_t)l * D * DFF, DFF, ws + WS_WGU + (size_t)(l * 2 + f) * SZ_WGU8, up ? 2 : 1, (float*)(ws + WS_SW) + (size_t)(l * 2 + f) * 2 * DFF, lds, sc, tid, lane, wave); }
        __syncthreads();
        bf16_t* WD = (bf16_t*)(ws + WS_WD); bf16_t* WIN = (bf16_t*)(ws + WS_WIN); bf16_t* WOUT = (bf16_t*)(ws + WS_WOUT);
        LAS unsigned* scr = (LAS unsigned*)(lds + wave * 8448);
        const int nshort = (NSTRIP % G) ? G - NSTRIP % G : 0, nextra = nshort * NWAVES * 2 < NITEM ? nshort * NWAVES * 2 : 0;
        for (int pass = 0; pass < 2; ++pass) {
            int it, step, end;
            if (pass == 0) { if (nextra == 0 || bx < G - nshort) continue; it = ((bx - (G - nshort)) * NWAVES + wave) * 2; step = 1; end = it + 2; }
            else { it = nextra + gw; step = NGW; end = NITEM; }
            for (; it < end; it += step) { int r = it;
                if (r < NB) { const int idx = r / I_F, l = idx >> 1, f = idx & 1; r -= idx * I_F; tr_item((f ? ap->in[21] : ap->in[4]) + (size_t)l * D * DFF, DFF, D, D, WD + (size_t)idx * SZ_WD, 0, scr, r, lane); continue; } r -= NB;
                if (r < NC) { const int l = r / I_IN; r -= l * I_IN; tr_item(ap->in[6] + (size_t)l * D * DIN, D, NBF, DIN, WIN + (size_t)l * SZ_WIN, 0, scr, r, lane); continue; } r -= NC;
                { const int l = r / I_OUT; r -= l * I_OUT; tr_item(ap->in[17] + (size_t)l * D * D, D, D, D, WOUT + (size_t)l * SZ_WOUT, 0, scr, r, lane); } } }
        }
        bf16_t* lruw = (bf16_t*)(ws + WS_LRUW);
        for (int o = vcu * 512 + tid; o < 2 * 2 * 8 * 128 * 128; o += G * 512) {
            const int i = o & 127, jj = (o >> 7) & 127, hh = (o >> 14) & 7, which = (o >> 17) & 1, l = o >> 18;
            const float* src = which ? ap->in[14] : ap->in[12];
            lruw[o] = (bf16_t)(pk2(src[((size_t)(l * 8 + hh) * 128 + i) * 128 + jj], 0.f) & 0xffffu); }
        for (int rep = 0; rep < REP_NORM; ++rep) norm_rows<2>(ap->in[0], ap->in[1], (void*)(ws + WS_H), (float*)(ws + WS_SA), gw, NGW, lane);
    }
    PH_END;

#pragma nounroll
    for (int i = 0; i < 4; ++i) {
        if (PH_ON) { GETARGS(); GEOM(); unsigned char* ws = ap->ws;
            pg8::Gemm g{(bf16_t*)(ws + WS_H), (bf16_t*)(ws + WS_WGU + (size_t)i * SZ_WGU8), M, 2 * DFF, D / 2}; pg8::StaticOrder S; S.init(M, 2 * DFF, G, bx);
            const float* sa = (const float*)(ws + WS_SA); const float* sw = (const float*)(ws + WS_SW) + (size_t)i * 2 * DFF;
            LAS float* tab = (LAS float*)(lds + SCALE_TAB_OFF);
            if (G == 256) { const int pm = 8 * (bx & 7) + ((bx >> 3) & 7);
                for (int t = tid; t < 256; t += NWAVES * 64) tab[t] = sa[256 * pm + t];
                for (int t = tid; t < 11 * 256; t += NWAVES * 64) tab[256 + t] = sw[256 * (4 * (t >> 8) + (bx >> 6)) + (t & 255)];
                __syncthreads(); }
            pg8::EpiSwiGLU8 E{(bf16_t*)(ws + WS_ACT), DFF, sa, sw, G == 256 ? (PG8_LAS const float*)tab : (PG8_LAS const float*)nullptr};
            for (int rep = 0; rep < REP_GU; ++rep) pg8::gemm_phase<pg8::EpiSwiGLU8, pg8::StaticOrder, PG8_ALIGN, PG8_SP2, true>(lds, g, S, E); }
        PH_END;
        if (PH_ON) { GETARGS(); GEOM(); unsigned char* ws = ap->ws;
            pg8::Gemm g{(bf16_t*)(ws + WS_ACT), (bf16_t*)(ws + WS_WD) + (size_t)i * SZ_WD, M, D, DFF}; pg8::StaticOrder S; S.init(M, D, G, bx);
            pg8::EpiDelta E{(bf16_t*)(ws + WS_DELTA), D}; for (int rep = 0; rep < REP_DOWN; ++rep) pg8::gemm_phase<pg8::EpiDelta, pg8::StaticOrder, PG8_ALIGN, PG8_SP2>(lds, g, S, E); }
        PH_END;
        if (PH_ON) { GETARGS(); GEOM(); const bf16_t* dl = (const bf16_t*)(ap->ws + WS_DELTA);
            if (i == 3) resnorm_rows<true, XBF16 != 0>(ap->out, (const bf16_t*)(ap->ws + WS_XB), true, dl, 0.5f, ap->in[22], ap->out, nullptr, nullptr, 0, nullptr, nullptr, gw, NGW, lane);
            else for (int rep = 0; rep < REP_NORM; ++rep) resnorm_rows<false, XBF16 != 0>((i == 0 && rep == 0) ? ap->in[0] : (const float*)ap->out, (const bf16_t*)(ap->ws + WS_XB), !(i == 0 && rep == 0), dl, rep == 0 ? 0.5f : 0.0f, (i & 1) == 0 ? ap->in[5] + (size_t)(i >> 1) * D : ap->in[1] + (size_t)D, ap->out, (bf16_t*)(ap->ws + WS_XB), (bf16_t*)(ap->ws + WS_H), i == 1 ? 1 : (N8 > 0 ? 2 : 0), ap->ws + (i == 1 ? WS_H : WS_Y), (float*)(ap->ws + WS_SA), gw, NGW, lane);
        }
        PH_END;
        if ((i & 1) == 0) {
            const int l = i >> 1;
            if (PH_ON) { GETARGS(); GEOM(); unsigned char* ws = ap->ws;
                const float* sa = (const float*)(ws + WS_SA); const float* sw = (const float*)(ws + WS_SWIN) + (size_t)l * N8;
                LAS float* tab = (LAS float*)(lds + SCALE_TAB_OFF);
                if (N8 > 0 && G == 256) { const int pm = 8 * (bx & 7) + ((bx >> 3) & 7);
                    for (int t = tid; t < 256; t += NWAVES * 64) tab[t] = sa[256 * pm + t];
                    for (int t = tid; t < (N8 / 1024) * 256; t += NWAVES * 64) tab[256 + t] = sw[256 * (4 * (t >> 8) + (bx >> 6)) + (t & 255)];
                    __syncthreads(); }
                for (int rep = 0; rep < REP_WIN; ++rep) {
                if (NBF > 0) { pg8::Gemm g{(bf16_t*)(ws + WS_H), (bf16_t*)(ws + WS_WIN) + (size_t)l * SZ_WIN, M, NBF, D}; pg8::StaticOrder S; S.init(M, NBF, G, bx);
                    pg8::EpiWin E{(bf16_t*)(ws + WS_ACT), DIN, (float*)(ws + WS_VPART)}; pg8::gemm_phase<pg8::EpiWin, pg8::StaticOrder, PG8_ALIGN, PG8_SP2>(lds, g, S, E); }
                if (N8 > 0) { pg8::Gemm g{(bf16_t*)(ws + WS_Y), (bf16_t*)(ws + WS_WIN + (size_t)l * SZ_WIN * 2 + (size_t)NBF * D * 2), M, N8, D / 2}; pg8::StaticOrder S; S.init(M, N8, G, bx);
                    pg8::EpiWin8 E{(bf16_t*)(ws + WS_ACT), DIN, (float*)(ws + WS_VPART), sa, sw, NBF / 256, G == 256 ? (PG8_LAS const float*)tab : (PG8_LAS const float*)nullptr};
                    pg8::gemm_phase<pg8::EpiWin8, pg8::StaticOrder, PG8_ALIGN, PG8_SP2, true>(lds, g, S, E); }
                } }
            PH_END;
            if (PH_ON) { GETARGS(); GEOM(); unsigned char* ws = ap->ws;
                for (int rep = 0; rep < REP_MIXA; ++rep) {
                gmlp_phase(lds, l, (const bf16_t*)(ws + WS_ACT), (bf16_t*)(ws + WS_Y), (const float*)(ws + WS_VPART), ap->in[8], ap->in[9], ap->in[7], tid, lane, wave, bx, G);
                lru_phase<0>(lds, l, (const bf16_t*)(ws + WS_ACT), (bf16_t*)(ws + WS_Y), (float*)(ws + WS_SUMM), (const bf16_t*)(ws + WS_LRUW), ap->in[10], ap->in[11], ap->in[13], ap->in[15], ap->in[16], tid, lane, wave, bx, G);
                }
            }
            PH_END;
            if (PH_ON) { GETARGS(); GEOM(); unsigned char* ws = ap->ws;
                for (int rep = 0; rep < REP_MIXB; ++rep)
                lru_phase<1>(lds, l, (const bf16_t*)(ws + WS_ACT), (bf16_t*)(ws + WS_Y), (float*)(ws + WS_SUMM), (const bf16_t*)(ws + WS_LRUW), ap->in[10], ap->in[11], ap->in[13], ap->in[15], ap->in[16], tid, lane, wave, bx, G);
            }
            PH_END;
            if (PH_ON) { GETARGS(); GEOM(); unsigned char* ws = ap->ws;
                pg8::Gemm g{(bf16_t*)(ws + WS_Y), (bf16_t*)(ws + WS_WOUT) + (size_t)l * SZ_WOUT, M, D, D}; pg8::StaticOrder S; S.init(M, D, G, bx);
                pg8::EpiDelta E{(bf16_t*)(ws + WS_DELTA), D}; for (int rep = 0; rep < REP_WOUT; ++rep) pg8::gemm_phase<pg8::EpiDelta, pg8::StaticOrder, PG8_ALIGN, PG8_SP2>(lds, g, S, E); }
            PH_END;
            if (PH_ON) { GETARGS(); GEOM(); for (int rep = 0; rep < REP_NORM; ++rep) resnorm_rows<false, XBF16 != 0>(ap->out, (const bf16_t*)(ap->ws + WS_XB), true, (const bf16_t*)(ap->ws + WS_DELTA), rep == 0 ? 1.0f : 0.0f, ap->in[18] + (size_t)l * D, ap->out, (bf16_t*)(ap->ws + WS_XB), (bf16_t*)(ap->ws + WS_H), 1, ap->ws + WS_H, (float*)(ap->ws + WS_SA), gw, NGW, lane); }
            PH_END;
        }
    }
#if defined(DUMMY_N) && DUMMY_N > 0
    if (PH_ON) { GETARGS(); GEOM(); unsigned char* ws = ap->ws;
#if defined(DUMMY_I8) && DUMMY_I8
        pg8::Gemm g{(bf16_t*)(ws + WS_H), (bf16_t*)(ws + WS_WGU), M, DUMMY_N, D / 2}; pg8::StaticOrder S; S.init(M, DUMMY_N, G, bx);
        pg8::EpiDummyI8 E{(bf16_t*)(ws + WS_ACT), DUMMY_N}; pg8::gemm_phase<pg8::EpiDummyI8, pg8::StaticOrder, PG8_ALIGN, PG8_SP2, true>(lds, g, S, E);
#else
        pg8::Gemm g{(bf16_t*)(ws + WS_H), (bf16_t*)(ws + WS_WGU), M, DUMMY_N, D}; pg8::StaticOrder S; S.init(M, DUMMY_N, G, bx);
        pg8::EpiDelta E{(bf16_t*)(ws + WS_ACT), DUMMY_N}; pg8::gemm_phase<pg8::EpiDelta, pg8::StaticOrder, PG8_ALIGN, PG8_SP2>(lds, g, S, E);
#endif
    }
    PH_END;
#endif
#undef PH_ON
#undef PH_END
}

extern "C" void kernel_launch(void* const* d_in, const int* in_sizes, int n_in, void* d_out, int out_size, void* d_ws, size_t ws_size, hipStream_t stream) {
    static int grid = 0;
    if (grid == 0) {
        if (n_in != 23 || in_sizes[0] != M * D || out_size != M * D || ws_size < WS_END) { fprintf(stderr, "kernel_launch: unexpected shapes (n_in %d, in0 %d, out %d, ws %zu); nothing launched\n", n_in, n_in > 0 ? in_sizes[0] : -1, out_size, ws_size); grid = -1; return; }
        int dev = 0, cus = 0;
        if (hipGetDevice(&dev) != hipSuccess || hipDeviceGetAttribute(&cus, hipDeviceAttributeMultiprocessorCount, dev) != hipSuccess) { fprintf(stderr, "kernel_launch: device query failed\n"); grid = -1; return; }
        if (hipFuncSetAttribute((const void*)mk_fwd, hipFuncAttributeMaxDynamicSharedMemorySize, LDS_BYTES) != hipSuccess) { fprintf(stderr, "kernel_launch: hipFuncSetAttribute failed\n"); grid = -1; return; }
        int per_cu = 0;
        if (hipOccupancyMaxActiveBlocksPerMultiprocessor(&per_cu, (const void*)mk_fwd, NWAVES * 64, LDS_BYTES) != hipSuccess || per_cu < 1) fprintf(stderr, "kernel_launch: note: occupancy query reports %d workgroups per CU\n", per_cu);
        (void)hipGetLastError();
        grid = cus - cus % 8;
    }
    if (grid < 0) return;
    if (hipMemsetAsync((char*)d_ws + WS_CTL, 0, CTL_ZERO_BYTES, stream) != hipSuccess) { fprintf(stderr, "kernel_launch: memset failed\n"); return; }
    Args a{};
    for (int i = 0; i < 23; ++i) a.in[i] = (const float*)d_in[i];
    a.out = (float*)d_out; a.ws = (unsigned char*)d_ws; a.pad = 0;
#if MK_MODE == 0
    a.ph_lo = 0; a.ph_hi = NPH; a.li = 0;
    hipLaunchKernelGGL(mk_fwd, dim3(grid), dim3(NWAVES * 64), LDS_BYTES, stream, a);
#else
    for (int p = 0; p < NPH; ++p) { a.ph_lo = p; a.ph_hi = p + 1; a.li = p; hipLaunchKernelGGL(mk_fwd, dim3(grid), dim3(NWAVES * 64), LDS_BYTES, stream, a); }
#endif
}
```

```cpp
#include <hip/hip_runtime.h>
#include <cstdio>
#include <cstdint>
#define PG8_ALIGN false
namespace pg8 {
#define PG8_LAS __attribute__((address_space(3)))
typedef unsigned short bf16_t;
typedef short bf16x8 __attribute__((ext_vector_type(8)));
typedef float f32x4 __attribute__((ext_vector_type(4)));
typedef unsigned u32x4 __attribute__((ext_vector_type(4)));
constexpr int BM = 256, BK = 64, HALF = 128, HTB = HALF * BK * 2  , STAGE_BYTES = 8 * HTB, NXCD = 8, WGM = 8;

__host__ __device__ __forceinline__ int lds_byte(int r, int c) { const int st = (r >> 4) * 2 + (c >> 5), rr = r & 15, cc = c & 31, ob = rr * 64 + cc * 2; return st * 1024 + (ob ^ (((ob >> 9) & 1) << 5)); }
__host__ __device__ __forceinline__ void stage_rc(int b, int& R, int& C) { const int st = b / 1024, sb = b % 1024, swz = sb ^ (((sb >> 9) & 1) << 5); R = (st >> 1) * 16 + swz / 64; C = (st & 1) * 32 + (swz % 64) / 2; }
__host__ __device__ __forceinline__ int perm32(int rho) { const int n = rho >> 4, i = rho & 15; return 8 * (i >> 2) + 4 * n + (i & 3); }

struct Unit { int pm, pn; };
struct Gemm { const bf16_t* A; const bf16_t* Bt; int M, N, K; };

struct StaticOrder {
    int nM, nN, nwg, G, c;
    __host__ __device__ void init(int M, int N, int G_, int c_) { nM = M / BM; nN = N / BM; nwg = nM * nN; G = G_; c = c_; }
    __host__ __device__ bool next(int i, Unit& u) const {
        const long L = (long)i * G + c; if (L >= nwg) return false;
        int wgid = (int)L; { const int q = nwg / NXCD, r = nwg % NXCD, xcd = wgid % NXCD, off = wgid / NXCD; wgid = (xcd < r ? xcd * (q + 1) : r * (q + 1) + (xcd - r) * q) + off; }
        const int nig = WGM * nN, gid = wgid / nig, fm = gid * WGM, gsz = (nM - fm) < WGM ? (nM - fm) : WGM;
        u.pm = fm + ((wgid % nig) % gsz); u.pn = (wgid % nig) / gsz; return true;
    }
    __device__ __forceinline__ void a_ready(const Unit&) const {}
    __device__ __forceinline__ void done(const Unit&) const {}
};
__device__ __forceinline__ unsigned cvt_pk_bf16(float lo, float hi) { unsigned r; asm volatile("v_cvt_pk_bf16_f32 %0, %1, %2" : "=v"(r) : "v"(lo), "v"(hi)); return r; }
typedef float f32x2 __attribute__((ext_vector_type(2)));
typedef unsigned u32x2 __attribute__((ext_vector_type(2)));
__device__ __forceinline__ float silu_f(float g) { return g * __builtin_amdgcn_rcpf(1.0f + __builtin_amdgcn_exp2f(-1.4426950408889634f * g)); }
__device__ __forceinline__ float gelu_tanh_f(float x) { const float t = x * (1.0f + 0.044715f * x * x); return x * __builtin_amdgcn_rcpf(1.0f + __builtin_amdgcn_exp2f(-2.3022081981f * t)); }

struct EpiSwiGLU {
    static constexpr bool PERM = true, AFTER_DRAIN = false;
    bf16_t* O; int ldc;
    __device__ __forceinline__ void operator()(const f32x4 (&acc)[2][2][4][2], const Unit& u, int wr, int wc, int fr, int fq) const {
        const int row0 = u.pm * BM + wr * 64 + fr, col0 = u.pn * HALF + wc * 32 + 8 * fq;
#pragma unroll
        for (int ai = 0; ai < 2; ++ai)
#pragma unroll
            for (int m = 0; m < 4; ++m) { bf16_t* rowp = O + (size_t)(row0 + ai * HALF + m * 16) * ldc + col0;
                const f32x4 g0 = acc[ai][0][m][0], g1 = acc[ai][0][m][1], u0 = acc[ai][1][m][0], u1 = acc[ai][1][m][1];
                f32x4 v0, v1;
#pragma unroll
                for (int j = 0; j < 4; ++j) { v0[j] = silu_f(g0[j]) * u0[j]; v1[j] = silu_f(g1[j]) * u1[j]; }
                u32x4 w; w.x = cvt_pk_bf16(v0[0], v0[1]); w.y = cvt_pk_bf16(v0[2], v0[3]); w.z = cvt_pk_bf16(v1[0], v1[1]); w.w = cvt_pk_bf16(v1[2], v1[3]);
                *(u32x4*)rowp = w; }
    }
};
struct EpiResid {
    static constexpr bool PERM = false, AFTER_DRAIN = false;
    const float* base; float* out; int ldc; float scale;
    __device__ __forceinline__ void operator()(const f32x4 (&acc)[2][2][4][2], const Unit& u, int wr, int wc, int fr, int fq) const {
        const int row0 = u.pm * BM + wr * 64 + fr, col0 = u.pn * BM + wc * 32 + 4 * fq;
#pragma unroll
        for (int ai = 0; ai < 2; ++ai) {
            f32x4 bs[4][2][2];
#pragma unroll
            for (int m = 0; m < 4; ++m) { const size_t off = (size_t)(row0 + ai * HALF + m * 16) * ldc + col0;
#pragma unroll
                for (int bj = 0; bj < 2; ++bj)
#pragma unroll
                    for (int n = 0; n < 2; ++n) bs[m][bj][n] = *(const f32x4*)(base + off + bj * HALF + n * 16); }
#pragma unroll
            for (int m = 0; m < 4; ++m) { const size_t off = (size_t)(row0 + ai * HALF + m * 16) * ldc + col0;
#pragma unroll
                for (int bj = 0; bj < 2; ++bj)
#pragma unroll
                    for (int n = 0; n < 2; ++n) *(f32x4*)(out + off + bj * HALF + n * 16) = bs[m][bj][n] + acc[ai][bj][m][n] * scale; }
            asm volatile("" ::: "memory"); }
    }
};
struct EpiDelta {
    static constexpr bool PERM = true, AFTER_DRAIN = false;
    bf16_t* O; int ldc;
    __device__ __forceinline__ void operator()(const f32x4 (&acc)[2][2][4][2], const Unit& u, int wr, int wc, int fr, int fq) const {
        const int row0 = u.pm * BM + wr * 64 + fr, col0 = u.pn * BM + wc * 32 + 8 * fq;
#pragma unroll
        for (int ai = 0; ai < 2; ++ai)
#pragma unroll
            for (int m = 0; m < 4; ++m) { bf16_t* rowp = O + (size_t)(row0 + ai * HALF + m * 16) * ldc + col0;
#pragma unroll
                for (int bj = 0; bj < 2; ++bj) { const f32x4 v0 = acc[ai][bj][m][0], v1 = acc[ai][bj][m][1];
                    u32x4 w; w.x = cvt_pk_bf16(v0[0], v0[1]); w.y = cvt_pk_bf16(v0[2], v0[3]); w.z = cvt_pk_bf16(v1[0], v1[1]); w.w = cvt_pk_bf16(v1[2], v1[3]);
                    *(u32x4*)(rowp + bj * HALF) = w; } }
    }
};
struct EpiWin {
    static constexpr bool PERM = true, AFTER_DRAIN = false;
    bf16_t* Z; int ldc; float* vpart;
    __device__ __forceinline__ void operator()(const f32x4 (&acc)[2][2][4][2], const Unit& u, int wr, int wc, int fr, int fq) const {
        const int row0 = u.pm * BM + wr * 64 + fr, col0 = u.pn * BM + wc * 32 + 8 * fq;
        const bool act = u.pn < 12, isv = (u.pn >= 4) && (u.pn < 8);
#pragma unroll
        for (int ai = 0; ai < 2; ++ai)
#pragma unroll
            for (int m = 0; m < 4; ++m) { const int row = row0 + ai * HALF + m * 16; bf16_t* rowp = Z + (size_t)row * ldc + col0; float ss = 0.f;
#pragma unroll
                for (int bj = 0; bj < 2; ++bj) { f32x4 v0 = acc[ai][bj][m][0], v1 = acc[ai][bj][m][1];
                    if (act) {
#pragma unroll
                        for (int j = 0; j < 4; ++j) { v0[j] = gelu_tanh_f(v0[j]); v1[j] = gelu_tanh_f(v1[j]); } }
                    ss += (v0[0] * v0[0] + v0[1] * v0[1]) + (v0[2] * v0[2] + v0[3] * v0[3]) + (v1[0] * v1[0] + v1[1] * v1[1]) + (v1[2] * v1[2] + v1[3] * v1[3]);
                    u32x4 w; w.x = cvt_pk_bf16(v0[0], v0[1]); w.y = cvt_pk_bf16(v0[2], v0[3]); w.z = cvt_pk_bf16(v1[0], v1[1]); w.w = cvt_pk_bf16(v1[2], v1[3]);
                    *(u32x4*)(rowp + bj * HALF) = w; }
                if (isv) { ss += __shfl_xor(ss, 16); ss += __shfl_xor(ss, 32); if (fq == 0) vpart[(size_t)row * 16 + (u.pn - 4) * 4 + wc] = ss; } }
    }
};
typedef int i32x4e __attribute__((ext_vector_type(4)));
struct EpiSwiGLU8 {
    static constexpr bool PERM = true, AFTER_DRAIN = false;
    bf16_t* O; int ldc; const float* sa; const float* sw;
    PG8_LAS const float* tab;
    __device__ __forceinline__ void operator()(const i32x4e (&acc)[2][2][4][2], const Unit& u, int wr, int wc, int fr, int fq) const {
        const int row0 = u.pm * BM + wr * 64 + fr, col0 = u.pn * HALF + wc * 32 + 8 * fq, brow = u.pn * BM + wc * 32 + 8 * fq;
        f32x4 sg0, sg1, su0, su1; float ra[2][4];
        if (tab) { PG8_LAS const float* t = tab + 256 + (u.pn >> 2) * 256 + wc * 32 + 8 * fq;
            sg0 = *(PG8_LAS const f32x4*)t; sg1 = *(PG8_LAS const f32x4*)(t + 4); su0 = *(PG8_LAS const f32x4*)(t + HALF); su1 = *(PG8_LAS const f32x4*)(t + HALF + 4);
#pragma unroll
            for (int ai = 0; ai < 2; ++ai)
#pragma unroll
                for (int m = 0; m < 4; ++m) ra[ai][m] = tab[wr * 64 + fr + ai * HALF + m * 16];
        } else { sg0 = *(const f32x4*)(sw + brow); sg1 = *(const f32x4*)(sw + brow + 4); su0 = *(const f32x4*)(sw + brow + HALF); su1 = *(const f32x4*)(sw + brow + HALF + 4);
#pragma unroll
            for (int ai = 0; ai < 2; ++ai)
#pragma unroll
                for (int m = 0; m < 4; ++m) ra[ai][m] = sa[row0 + ai * HALF + m * 16]; }
        const f32x4 ss0 = sg0 * su0, ss1 = sg1 * su1, nc0 = sg0 * (-1.4426950408889634f), nc1 = sg1 * (-1.4426950408889634f);
#pragma unroll
        for (int ai = 0; ai < 2; ++ai)
#pragma unroll
            for (int m = 0; m < 4; ++m) { bf16_t* rowp = O + (size_t)(row0 + ai * HALF + m * 16) * ldc + col0; const float r = ra[ai][m], r2 = r * r;
                const i32x4e ig0 = acc[ai][0][m][0], ig1 = acc[ai][0][m][1], iu0 = acc[ai][1][m][0], iu1 = acc[ai][1][m][1];
                u32x4 w;
#pragma unroll
                for (int h = 0; h < 2; ++h) {
                    const f32x2 ga = {(float)ig0[2 * h], (float)ig0[2 * h + 1]}, gb = {(float)ig1[2 * h], (float)ig1[2 * h + 1]}, ua = {(float)iu0[2 * h], (float)iu0[2 * h + 1]}, ub = {(float)iu1[2 * h], (float)iu1[2 * h + 1]};
                    const f32x2 na = {nc0[2 * h], nc0[2 * h + 1]}, nb = {nc1[2 * h], nc1[2 * h + 1]}, sa2 = {ss0[2 * h], ss0[2 * h + 1]}, sb2 = {ss1[2 * h], ss1[2 * h + 1]};
                    const f32x2 ta = (ga * na) * r, tb = (gb * nb) * r;
                    f32x2 ea, eb; ea.x = __builtin_amdgcn_exp2f(ta.x); ea.y = __builtin_amdgcn_exp2f(ta.y); eb.x = __builtin_amdgcn_exp2f(tb.x); eb.y = __builtin_amdgcn_exp2f(tb.y);
                    const f32x2 da = ea + 1.0f, db = eb + 1.0f;
                    f32x2 ca, cb; ca.x = __builtin_amdgcn_rcpf(da.x); ca.y = __builtin_amdgcn_rcpf(da.y); cb.x = __builtin_amdgcn_rcpf(db.x); cb.y = __builtin_amdgcn_rcpf(db.y);
                    const f32x2 va = ((ga * ua) * (sa2 * r2)) * ca, vb = ((gb * ub) * (sb2 * r2)) * cb;
                    const unsigned pa = cvt_pk_bf16(va.x, va.y), pb = cvt_pk_bf16(vb.x, vb.y);
                    if (h == 0) { w.x = pa; w.z = pb; } else { w.y = pa; w.w = pb; } }
                *(u32x4*)rowp = w; }
    }
};
struct EpiWin8 {
    static constexpr bool PERM = true, AFTER_DRAIN = false;
    bf16_t* Z; int ldc; float* vpart; const float* sa; const float* sw; int pnoff;
    PG8_LAS const float* tab;
    __device__ __forceinline__ void operator()(const i32x4e (&acc)[2][2][4][2], const Unit& u, int wr, int wc, int fr, int fq) const {
        const int gpn = u.pn + pnoff, row0 = u.pm * BM + wr * 64 + fr, lcol0 = u.pn * BM + wc * 32 + 8 * fq, col0 = lcol0 + pnoff * BM;
        const bool act = gpn < 12, isv = (gpn >= 4) && (gpn < 8);
        f32x4 s[2][2]; float ra[2][4];
        if (tab) { PG8_LAS const float* t = tab + 256 + (u.pn >> 2) * 256 + wc * 32 + 8 * fq;
#pragma unroll
            for (int bj = 0; bj < 2; ++bj) { s[bj][0] = *(PG8_LAS const f32x4*)(t + bj * HALF); s[bj][1] = *(PG8_LAS const f32x4*)(t + bj * HALF + 4); }
#pragma unroll
            for (int ai = 0; ai < 2; ++ai)
#pragma unroll
                for (int m = 0; m < 4; ++m) ra[ai][m] = tab[wr * 64 + fr + ai * HALF + m * 16];
        } else {
#pragma unroll
            for (int bj = 0; bj < 2; ++bj) { s[bj][0] = *(const f32x4*)(sw + lcol0 + bj * HALF); s[bj][1] = *(const f32x4*)(sw + lcol0 + bj * HALF + 4); }
#pragma unroll
            for (int ai = 0; ai < 2; ++ai)
#pragma unroll
                for (int m = 0; m < 4; ++m) ra[ai][m] = sa[row0 + ai * HALF + m * 16]; }
#pragma unroll
        for (int ai = 0; ai < 2; ++ai)
#pragma unroll
            for (int m = 0; m < 4; ++m) { const int row = row0 + ai * HALF + m * 16; bf16_t* rowp = Z + (size_t)row * ldc + col0; float ss = 0.f; const float r = ra[ai][m];
#pragma unroll
                for (int bj = 0; bj < 2; ++bj) { const i32x4e i0 = acc[ai][bj][m][0], i1 = acc[ai][bj][m][1]; const f32x4 s0 = s[bj][0] * r, s1 = s[bj][1] * r; f32x4 v0, v1;
#pragma unroll
                    for (int j = 0; j < 4; ++j) { v0[j] = (float)i0[j] * s0[j]; v1[j] = (float)i1[j] * s1[j]; }
                    if (act) {
#pragma unroll
                        for (int j = 0; j < 4; ++j) { v0[j] = gelu_tanh_f(v0[j]); v1[j] = gelu_tanh_f(v1[j]); } }
                    ss += (v0[0] * v0[0] + v0[1] * v0[1]) + (v0[2] * v0[2] + v0[3] * v0[3]) + (v1[0] * v1[0] + v1[1] * v1[1]) + (v1[2] * v1[2] + v1[3] * v1[3]);
                    u32x4 w; w.x = cvt_pk_bf16(v0[0], v0[1]); w.y = cvt_pk_bf16(v0[2], v0[3]); w.z = cvt_pk_bf16(v1[0], v1[1]); w.w = cvt_pk_bf16(v1[2], v1[3]);
                    *(u32x4*)(rowp + bj * HALF) = w; }
                if (isv) { ss += __shfl_xor(ss, 16); ss += __shfl_xor(ss, 32); if (fq == 0) vpart[(size_t)row * 16 + (gpn - 4) * 4 + wc] = ss; } }
    }
};
struct EpiDummyI8 {
    static constexpr bool PERM = true, AFTER_DRAIN = false;
    bf16_t* O; int ldc;
    __device__ __forceinline__ void operator()(const i32x4e (&acc)[2][2][4][2], const Unit& u, int wr, int wc, int fr, int fq) const {
        const int row0 = u.pm * BM + wr * 64 + fr, col0 = u.pn * BM + wc * 32 + 8 * fq;
#pragma unroll
        for (int ai = 0; ai < 2; ++ai)
#pragma unroll
            for (int m = 0; m < 4; ++m) { bf16_t* rowp = O + (size_t)(row0 + ai * HALF + m * 16) * ldc + col0;
#pragma unroll
                for (int bj = 0; bj < 2; ++bj) { const i32x4e v0 = acc[ai][bj][m][0], v1 = acc[ai][bj][m][1];
                    u32x4 w; w.x = cvt_pk_bf16((float)v0[0], (float)v0[1]); w.y = cvt_pk_bf16((float)v0[2], (float)v0[3]); w.z = cvt_pk_bf16((float)v1[0], (float)v1[1]); w.w = cvt_pk_bf16((float)v1[2], (float)v1[3]);
                    *(u32x4*)(rowp + bj * HALF) = w; } }
    }
};
typedef int i32x4 __attribute__((ext_vector_type(4)));
template <bool I8> struct AccSel { typedef f32x4 type; };
template <> struct AccSel<true> { typedef i32x4 type; };
template <class Epi, class Sched, bool ALIGN_EPI = false, bool SP2 = false, bool I8 = false>
__device__ __forceinline__ void gemm_phase(PG8_LAS unsigned char* lds, const Gemm g, const Sched& S, const Epi& E) {
    int tid = threadIdx.x; asm volatile("" : "+v"(tid));
    const int wid = __builtin_amdgcn_readfirstlane(tid >> 6), lane = tid & 63, wr = wid >> 2, wc = wid & 3, fr = lane & 15, fq = lane >> 4;
    const int K = g.K, nt = K / BK;
    unsigned voffA[2], voffB[2];
#pragma unroll
    for (int i = 0; i < 2; ++i) { int R, C; stage_rc(tid * 16 + i * 8192, R, C); const int Rb = Epi::PERM ? ((R & ~31) + perm32(R & 31)) : R;
        voffA[i] = (unsigned)(R * K + C) * 2u; voffB[i] = (unsigned)(Rb * K + C) * 2u; }
    const size_t kstep = (size_t)(BK * 2);
    const size_t hstep = (size_t)HALF * K * 2;
    const size_t tstep = 2 * hstep;
    const unsigned ldsw = (unsigned)wid * 1024u;
    const int aoff = lds_byte(wr * 64 + fr, fq * 8), boff = lds_byte(wc * 32 + fr, fq * 8);
#define PG8_SA(b, h) (((b) * 2 + (h)) * HTB)
#define PG8_SB(b, h) ((4 + (b) * 2 + (h)) * HTB)
#define PG8_STAGE(bufoff, gbase, voff) do { _Pragma("unroll") for (int _i = 0; _i < 2; ++_i) \
        __builtin_amdgcn_global_load_lds((const unsigned*)((const char*)(gbase) + (voff)[_i]), (PG8_LAS unsigned*)(lds + (bufoff) + ldsw + _i * 8192), 16, 0, 0); } while (0)
#define PG8_LDA(dst, b, h) do { _Pragma("unroll") for (int m = 0; m < 4; ++m) _Pragma("unroll") for (int k = 0; k < 2; ++k) dst[m][k] = *(const PG8_LAS bf16x8*)(lds + PG8_SA(b, h) + aoff + m * 2048 + k * 1024); } while (0)
#define PG8_LDB(dst, b, h) do { _Pragma("unroll") for (int n = 0; n < 2; ++n) _Pragma("unroll") for (int k = 0; k < 2; ++k) dst[n][k] = *(const PG8_LAS bf16x8*)(lds + PG8_SB(b, h) + boff + n * 2048 + k * 1024); } while (0)
#define PG8_MMA(ai, bj, At, Bt) do { __builtin_amdgcn_s_setprio(1); _Pragma("unroll") for (int m = 0; m < 4; ++m) _Pragma("unroll") for (int n = 0; n < 2; ++n) _Pragma("unroll") for (int k = 0; k < 2; ++k) { \
        if constexpr (I8) acc[ai][bj][m][n] = __builtin_amdgcn_mfma_i32_16x16x64_i8(__builtin_bit_cast(i32x4, Bt[n][k]), __builtin_bit_cast(i32x4, At[m][k]), acc[ai][bj][m][n], 0, 0, 0); \
        else acc[ai][bj][m][n] = __builtin_amdgcn_mfma_f32_16x16x32_bf16(Bt[n][k], At[m][k], acc[ai][bj][m][n], 0, 0, 0); } __builtin_amdgcn_s_setprio(0); } while (0)
#define PG8_WAIT_V(n) asm volatile("s_waitcnt vmcnt(" #n ")" ::: "memory")
#define PG8_WAIT_L(n) asm volatile("s_waitcnt lgkmcnt(" #n ")" ::: "memory")
#define PG8_BAR __builtin_amdgcn_s_barrier()
#define PG8_SCHED __builtin_amdgcn_sched_barrier(0)
    Unit cur, nxt; int ui = 0;
    if (!S.next(0, cur)) return;
    typedef typename AccSel<I8>::type acc_t;
    acc_t acc[2][2][4][2];
#pragma unroll
    for (int a = 0; a < 2; ++a)
#pragma unroll
        for (int b = 0; b < 2; ++b)
#pragma unroll
            for (int m = 0; m < 4; ++m)
#pragma unroll
                for (int n = 0; n < 2; ++n) acc[a][b][m][n] = (acc_t){0, 0, 0, 0};
    bf16x8 At[4][2], B0[2][2], B1[2][2];
    const char* cA = (const char*)g.A + (size_t)cur.pm * tstep; const char* cB = (const char*)g.Bt + (size_t)cur.pn * tstep;
    S.a_ready(cur);
    if constexpr (SP2) {
        PG8_STAGE(PG8_SB(0, 0), cB, voffB); PG8_STAGE(PG8_SB(0, 1), cB + hstep, voffB); PG8_STAGE(PG8_SA(0, 0), cA, voffA); PG8_STAGE(PG8_SA(0, 1), cA + hstep, voffA);
        if (wr == 1) PG8_BAR;
        PG8_WAIT_V(2); PG8_BAR;
        PG8_STAGE(PG8_SB(1, 0), cB + kstep, voffB); PG8_STAGE(PG8_SA(1, 0), cA + kstep, voffA); PG8_STAGE(PG8_SB(1, 1), cB + hstep + kstep, voffB);
        PG8_WAIT_V(6); PG8_BAR;
    } else {
        PG8_STAGE(PG8_SB(0, 0), cB, voffB); PG8_STAGE(PG8_SA(0, 0), cA, voffA); PG8_STAGE(PG8_SB(0, 1), cB + hstep, voffB); PG8_STAGE(PG8_SA(0, 1), cA + hstep, voffA);
        if (wr == 1) PG8_BAR;
        PG8_WAIT_V(4); PG8_BAR;
        PG8_STAGE(PG8_SB(1, 0), cB + kstep, voffB); PG8_STAGE(PG8_SA(1, 0), cA + kstep, voffA); PG8_STAGE(PG8_SB(1, 1), cB + hstep + kstep, voffB);
        PG8_WAIT_V(6); PG8_BAR;
    }
    for (;;) {
        const bool has_next = S.next(ui + 1, nxt);
        const char* nA = has_next ? (const char*)g.A + (size_t)nxt.pm * tstep : cA; const char* nB = has_next ? (const char*)g.Bt + (size_t)nxt.pn * tstep : cB;
        for (int t = 0; t < nt; t += 2) {
            const bool last = (t == nt - 2);
            const char* a1 = cA + (size_t)(t + 1) * kstep;
            const char* a2 = last ? nA : cA + (size_t)(t + 2) * kstep; const char* b2 = last ? nB : cB + (size_t)(t + 2) * kstep;
            const char* a3 = a2 + kstep; const char* b3 = b2 + kstep;
            if (last && has_next) S.a_ready(nxt);
            if constexpr (SP2) {
            PG8_LDB(B0, 0, 0); PG8_LDB(B1, 0, 1); PG8_SCHED; PG8_LDA(At, 0, 0); PG8_STAGE(PG8_SA(1, 1), a1 + hstep, voffA);
            PG8_WAIT_V(8); PG8_WAIT_L(0); PG8_BAR; PG8_MMA(0, 0, At, B0); PG8_MMA(0, 1, At, B1); PG8_BAR; PG8_SCHED;
            PG8_LDA(At, 0, 1); PG8_STAGE(PG8_SB(0, 0), b2, voffB); PG8_STAGE(PG8_SB(0, 1), b2 + hstep, voffB); PG8_STAGE(PG8_SA(0, 0), a2, voffA);
            PG8_WAIT_V(8); PG8_WAIT_L(0); PG8_BAR; PG8_MMA(1, 0, At, B0); PG8_MMA(1, 1, At, B1); PG8_BAR; PG8_SCHED;
            PG8_LDB(B0, 1, 0); PG8_LDB(B1, 1, 1); PG8_SCHED; PG8_LDA(At, 1, 0); PG8_STAGE(PG8_SA(0, 1), a2 + hstep, voffA);
            PG8_WAIT_V(8); PG8_WAIT_L(0); PG8_BAR; PG8_MMA(0, 0, At, B0); PG8_MMA(0, 1, At, B1); PG8_BAR; PG8_SCHED;
            PG8_LDA(At, 1, 1); PG8_STAGE(PG8_SB(1, 0), b3, voffB); PG8_STAGE(PG8_SB(1, 1), b3 + hstep, voffB); PG8_STAGE(PG8_SA(1, 0), a3, voffA);
            PG8_WAIT_V(8); PG8_WAIT_L(0); PG8_BAR; PG8_MMA(1, 0, At, B0); PG8_MMA(1, 1, At, B1); PG8_BAR; PG8_SCHED;
            } else {
            PG8_LDB(B0, 0, 0); PG8_SCHED; PG8_LDA(At, 0, 0); PG8_STAGE(PG8_SA(1, 1), a1 + hstep, voffA);
            PG8_WAIT_L(8); PG8_BAR; PG8_WAIT_L(0); PG8_MMA(0, 0, At, B0); PG8_BAR; PG8_SCHED;
            PG8_LDB(B1, 0, 1); PG8_STAGE(PG8_SB(0, 0), b2, voffB);
            PG8_BAR; PG8_WAIT_L(0); PG8_MMA(0, 1, At, B1); PG8_BAR;
            PG8_LDA(At, 0, 1); PG8_STAGE(PG8_SA(0, 0), a2, voffA);
            PG8_BAR; PG8_WAIT_L(0); PG8_MMA(1, 0, At, B0); PG8_BAR; PG8_SCHED;
            PG8_STAGE(PG8_SB(0, 1), b2 + hstep, voffB);
            PG8_WAIT_V(6); PG8_BAR; PG8_MMA(1, 1, At, B1); PG8_BAR;
            PG8_LDB(B0, 1, 0); PG8_SCHED; PG8_LDA(At, 1, 0); PG8_STAGE(PG8_SA(0, 1), a2 + hstep, voffA);
            PG8_WAIT_L(8); PG8_BAR; PG8_WAIT_L(0); PG8_MMA(0, 0, At, B0); PG8_BAR; PG8_SCHED;
            PG8_LDB(B1, 1, 1); PG8_STAGE(PG8_SB(1, 0), b3, voffB);
            PG8_BAR; PG8_WAIT_L(0); PG8_MMA(0, 1, At, B1); PG8_BAR;
            PG8_LDA(At, 1, 1); PG8_STAGE(PG8_SA(1, 0), a3, voffA);
            PG8_BAR; PG8_WAIT_L(0); PG8_MMA(1, 0, At, B0); PG8_BAR; PG8_SCHED;
            PG8_STAGE(PG8_SB(1, 1), b3 + hstep, voffB);
            PG8_WAIT_V(6); PG8_BAR; PG8_MMA(1, 1, At, B1); PG8_BAR;
            }
        }
        if constexpr (ALIGN_EPI) { if (wr == 0) PG8_BAR; }
        if constexpr (!Epi::AFTER_DRAIN) { E(acc, cur, wr, wc, fr, fq); S.done(cur); }
        if (!has_next) break;
#pragma unroll
        for (int a = 0; a < 2; ++a)
#pragma unroll
            for (int b = 0; b < 2; ++b)
#pragma unroll
                for (int m = 0; m < 4; ++m)
#pragma unroll
                    for (int n = 0; n < 2; ++n) acc[a][b][m][n] = (acc_t){0, 0, 0, 0};
        cur = nxt; cA = nA; cB = nB; ++ui;
        if constexpr (ALIGN_EPI) { if (wr == 1) PG8_BAR; }
    }
    PG8_WAIT_V(0);
    if constexpr (!ALIGN_EPI) { if (wr == 0) PG8_BAR; }
    PG8_BAR;
    if constexpr (Epi::AFTER_DRAIN) { E.fused(acc, cur, wr, wc, fr, fq, lds, wid, lane); S.done(cur); }
#undef PG8_SA
#undef PG8_SB
#undef PG8_STAGE
#undef PG8_LDA
#undef PG8_LDB
#undef PG8_MMA
#undef PG8_WAIT_V
#undef PG8_WAIT_L
#undef PG8_BAR
#undef PG8_SCHED
}
}
constexpr int BATCH = 4, SEQ = 4096, D = 2048, M = BATCH * SEQ, DFF = 5632, DIN = 4096, DG = 1024;
constexpr float EPS = 1e-6f;
constexpr int NWAVES = 8;
#ifndef PG8_ALIGN
#define PG8_ALIGN true
#endif
#ifndef PG8_SP2
#define PG8_SP2 true
#endif
#ifndef MK_MODE
#define MK_MODE 0
#endif
#ifndef REP_PRO
#define REP_PRO 1
#endif
#ifndef REP_NORM
#define REP_NORM 1
#endif
#ifndef REP_MIXA
#define REP_MIXA 1
#endif
#ifndef REP_MIXB
#define REP_MIXB 1
#endif
#ifndef REP_GU
#define REP_GU 1
#endif
#ifndef REP_DOWN
#define REP_DOWN 1
#endif
#ifndef REP_WIN
#define REP_WIN 1
#endif
#ifndef REP_WOUT
#define REP_WOUT 1
#endif
#ifndef W8_FROM
#define W8_FROM 8
#endif
#ifndef XBF16
#define XBF16 1
#endif
#if defined(DUMMY_N) && DUMMY_N > 0
constexpr int NPH = 24;
#else
constexpr int NPH = 23;
#endif

constexpr size_t MiB = 1u << 20;
constexpr size_t WS_CTL = 0, CTL_ZERO_BYTES = (MK_MODE == 0) ? 64 * 1024 : 1 * MiB;
constexpr size_t WS_VPART = 1 * MiB;
constexpr size_t WS_SUMM = 2 * MiB;
constexpr size_t WS_SA = 5 * MiB;
constexpr size_t WS_SW = 6 * MiB;
constexpr size_t WS_LRUW = 4 * MiB;
constexpr size_t SZ_WGU8 = (size_t)2 * DFF * D;
constexpr size_t WS_WGU = 8 * MiB, SZ_WGU = (size_t)2 * DFF * D;
constexpr size_t WS_WD = 184 * MiB, SZ_WD = (size_t)D * DFF;
constexpr size_t WS_WIN = 272 * MiB, SZ_WIN = (size_t)DIN * D;
constexpr int NBF = W8_FROM * 256, N8 = DIN - NBF;
constexpr size_t WS_SWIN = 7 * MiB;
static_assert(N8 == 0 || (N8 % 1024 == 0 && NBF % 1024 == 0), "W_in split: whole rounds of 4 column tiles on each side");
constexpr size_t WS_WOUT = 304 * MiB, SZ_WOUT = (size_t)D * D;
constexpr size_t WS_H = 320 * MiB;
constexpr size_t WS_Y = 384 * MiB;
constexpr size_t WS_ACT = 448 * MiB;
constexpr size_t WS_DELTA = 624 * MiB;
constexpr size_t WS_XB = 96 * MiB;
constexpr size_t WS_END = 688 * MiB;
static_assert(WS_WGU + 4 * SZ_WGU * 2 <= WS_WD && WS_WD + 4 * SZ_WD * 2 <= WS_WIN && WS_WIN + 2 * SZ_WIN * 2 <= WS_WOUT && WS_WOUT + 2 * SZ_WOUT * 2 <= WS_H, "ws map (weights)");
static_assert(WS_H + (size_t)M * D * 2 <= WS_Y && WS_Y + (size_t)M * D * 2 <= WS_ACT && WS_ACT + (size_t)M * DFF * 2 <= WS_DELTA && WS_DELTA + (size_t)M * D * 2 <= WS_END && WS_WGU + 4 * SZ_WGU8 <= WS_XB && WS_XB + (size_t)M * D * 2 <= WS_WD, "ws map (activations)");
constexpr int CW_BAR = 4096;
constexpr int RING_BYTES = 131072;
constexpr int LDSCTL_OFF = RING_BYTES, MISC_OFF = 147456 - 128;
constexpr int LDS_BYTES = 147456;
constexpr int SCALE_TAB_OFF = LDSCTL_OFF + 1024;
static_assert(SCALE_TAB_OFF + 12 * 1024 <= MISC_OFF && MISC_OFF + 128 <= LDS_BYTES, "LDS map");

#define LAS __attribute__((address_space(3)))
typedef unsigned short bf16_t;
typedef float f32x4 __attribute__((ext_vector_type(4)));
typedef float f32x2 __attribute__((ext_vector_type(2)));
typedef unsigned u32x4 __attribute__((ext_vector_type(4)));
typedef unsigned u32x2 __attribute__((ext_vector_type(2)));
typedef short bf16x8 __attribute__((ext_vector_type(8)));
typedef short s16x4 __attribute__((ext_vector_type(4)));
#define LDS_WAIT() asm volatile("s_waitcnt lgkmcnt(0)" ::: "memory")
__device__ __forceinline__ unsigned pk2(float lo, float hi) { return pg8::cvt_pk_bf16(lo, hi); }
__device__ __forceinline__ float bflo(unsigned w) { return __uint_as_float(w << 16); }
__device__ __forceinline__ float bfhi(unsigned w) { return __uint_as_float(w & 0xffff0000u); }
__device__ __forceinline__ float wave_sum(float v) {
#pragma unroll
    for (int o = 1; o < 64; o <<= 1) v += __shfl_xor(v, o);
    return v;
}
__device__ __forceinline__ float wave_max(float v) {
#pragma unroll
    for (int o = 1; o < 64; o <<= 1) v = fmaxf(v, __shfl_xor(v, o));
    return v;
}
__device__ __forceinline__ unsigned pack_i8x4(f32x4 y, float inv) {
    const int q0 = (int)__builtin_rintf(y[0] * inv), q1 = (int)__builtin_rintf(y[1] * inv), q2 = (int)__builtin_rintf(y[2] * inv), q3 = (int)__builtin_rintf(y[3] * inv);
    return ((unsigned)q0 & 255u) | (((unsigned)q1 & 255u) << 8) | (((unsigned)q2 & 255u) << 16) | ((unsigned)q3 << 24);
}
__device__ __forceinline__ void store_row_q8(const f32x4 (&y)[8], unsigned char* H8, float* SA, int m, int lane) {
    float am = 0.f;
#pragma unroll
    for (int j = 0; j < 8; ++j) am = fmaxf(fmaxf(am, fmaxf(fabsf(y[j][0]), fabsf(y[j][1]))), fmaxf(fabsf(y[j][2]), fabsf(y[j][3])));
    am = wave_max(am);
    const float inv = am > 0.f ? 127.0f / am : 0.f;
    unsigned* o = (unsigned*)(H8 + (size_t)m * D) + lane;
#pragma unroll
    for (int j = 0; j < 8; ++j) o[64 * j] = pack_i8x4(y[j], inv);
    if (lane == 0) SA[m] = am * (1.0f / 127.0f);
}
__device__ __forceinline__ float sigmoid_f(float x) { return __builtin_amdgcn_rcpf(1.0f + __builtin_amdgcn_exp2f(-1.4426950408889634f * x)); }

#define XB_TMO      128
#define XB_XCNT(j)  (256  + 64 * (j))
#define XB_XSUB(j)  (1280 + 64 * (j))
#define XB_XGEN(j)  (2304 + 64 * (j))
#define XB_TOP      3328
#define XB_TOPGEN   3392
#define XCD_BAR_WORDS 3456
#define XB_SPIN_CAP (1u << 18)

__device__ __forceinline__ unsigned xb_ld(unsigned* p)              { return __hip_atomic_load(p, __ATOMIC_RELAXED, __HIP_MEMORY_SCOPE_AGENT); }
__device__ __forceinline__ unsigned xb_add(unsigned* p, unsigned v) { return __hip_atomic_fetch_add(p, v, __ATOMIC_RELAXED, __HIP_MEMORY_SCOPE_AGENT); }
__device__ __forceinline__ unsigned xb_xcc_id() { return (unsigned)__builtin_amdgcn_s_getreg((3 << 11) | 20) & 0xFu; }
#define XB_SPIN(cond, bar) do { unsigned _sp = 0; while (cond) { __builtin_amdgcn_s_sleep(1); \
    if ((++_sp & 255u) == 0u) { if (xb_ld(&(bar)[XB_TMO])) break; if (_sp > XB_SPIN_CAP) { atomicAdd(&(bar)[XB_TMO], 1u); break; } } } } while (0)

struct XcdBarrier {
    unsigned* bar; unsigned x;
    volatile LAS unsigned* st;
};

__device__ __forceinline__ XcdBarrier xcd_barrier_post(unsigned* bar, volatile LAS unsigned* st) {
    XcdBarrier b; b.bar = bar; b.x = xb_xcc_id(); b.st = st;
    if (threadIdx.x == 0) (void)xb_add(&bar[XB_XCNT(b.x)], 1u);
    return b;
}
__device__ __forceinline__ void xcd_barrier_complete(unsigned* bar, unsigned x, unsigned& nloc, unsigned& nx) {
    const unsigned G = gridDim.x * gridDim.y * gridDim.z;
    unsigned sum, cnt, mine, sp = 0u;
    for (;;) {
        sum = 0u; cnt = 0u; mine = 0u;
#pragma unroll
        for (unsigned j = 0; j < 16; ++j) { const unsigned c = xb_ld(&bar[XB_XCNT(j)]); sum += c; cnt += (c > 0u) ? 1u : 0u; mine = (j == x) ? c : mine; }
        if (sum == G) break;
        __builtin_amdgcn_s_sleep(1);
        if ((++sp & 255u) == 0u) { if (xb_ld(&bar[XB_TMO])) break; if (sp > XB_SPIN_CAP) { atomicAdd(&bar[XB_TMO], 1u); break; } }
    }
    nloc = mine > 0u ? mine : 1u; nx = cnt > 0u ? cnt : 1u;
}

__device__ __forceinline__ void xcd_barrier(const XcdBarrier& b) {
    asm volatile("s_waitcnt vmcnt(0)" ::: "memory");
    __syncthreads();
    if (threadIdx.x == 0) {
        unsigned* bar = b.bar;
        __builtin_amdgcn_s_waitcnt(0);
        unsigned nloc = b.st[0], nx = b.st[1];
        if (nloc == 0u) { xcd_barrier_complete(bar, b.x, nloc, nx); b.st[0] = nloc; b.st[1] = nx; }
        const unsigned old = xb_add(&bar[XB_XSUB(b.x)], 1u);
        const unsigned gen = old / nloc;
        if (old + 1u == (gen + 1u) * nloc) {
            __builtin_amdgcn_fence(__ATOMIC_RELEASE, "agent");
            asm volatile("s_waitcnt vmcnt(0)" ::: "memory");
            const unsigned og = xb_add(&bar[XB_TOP], 1u);
            const unsigned tg = og / nx;
            if (og + 1u == (tg + 1u) * nx) xb_add(&bar[XB_TOPGEN], 1u);
            else XB_SPIN(xb_ld(&bar[XB_TOPGEN]) == tg, bar);
            __builtin_amdgcn_fence(__ATOMIC_ACQUIRE, "agent");
            xb_add(&bar[XB_XGEN(b.x)], 1u);
            asm volatile("s_waitcnt vmcnt(0)" ::: "memory");
        } else {
            XB_SPIN(xb_ld(&bar[XB_XGEN(b.x)]) == gen, bar);
            __builtin_amdgcn_fence(__ATOMIC_ACQUIRE, "agent");
            asm volatile("s_waitcnt vmcnt(0)" ::: "memory");
        }
    }
    __syncthreads();
}

__device__ __forceinline__ void tr_item(const float* W, int K, int N, int ldn, bf16_t* WT, int mode, LAS unsigned* scr, int item, int lane) {
    const int nblk = N >> 6, kb = item / nblk, nb = item - kb * nblk, k0 = kb << 6, n0 = nb << 6;
    const int kr = lane >> 4, c4 = lane & 15;
    f32x4 va[8], vb[8];
#pragma unroll
    for (int i = 0; i < 8; ++i) { const float* p = W + (size_t)(k0 + 8 * i + 2 * kr) * ldn + n0 + 4 * c4; va[i] = *(const f32x4*)p; vb[i] = *(const f32x4*)(p + ldn); }
#pragma unroll
    for (int i = 0; i < 8; ++i)
#pragma unroll
        for (int e = 0; e < 4; ++e) scr[(4 * i + kr) * 65 + 4 * c4 + e] = pk2(va[i][e], vb[i][e]);
    LDS_WAIT();
    const int nr = lane >> 3, c = lane & 7;
#pragma unroll
    for (int pp = 0; pp < 8; ++pp) { const int n = 8 * pp + nr; u32x4 o;
        o.x = scr[(4 * c + 0) * 65 + n]; o.y = scr[(4 * c + 1) * 65 + n]; o.z = scr[(4 * c + 2) * 65 + n]; o.w = scr[(4 * c + 3) * 65 + n];
        const int ng = n0 + n; const int orow = (mode == 0) ? ng : (((ng >> 7) << 8) + (ng & 127) + (mode == 2 ? 128 : 0));
        *(u32x4*)(WT + (size_t)orow * K + k0 + 8 * c) = o; }
    LDS_WAIT();
}
__device__ __forceinline__ void strip_q8(const float* W, int ldw, unsigned char* WT8, int mode, float* sw, LAS unsigned char* lds, int sc, int tid, int lane, int wave) {
    constexpr int PITCH = 4112;
    LAS float* CM = (LAS float*)(lds + 133120);
    const int n0 = 32 * sc, kr = lane >> 3, c4 = lane & 7, kbase = 256 * wave;
    __syncthreads();
    f32x4 mx = {0.f, 0.f, 0.f, 0.f};
#pragma unroll
    for (int hb = 0; hb < 2; ++hb) { f32x4 ra[8], rb[8];
#pragma unroll
        for (int i = 0; i < 8; ++i) { const float* p = W + (size_t)(kbase + 128 * hb + 16 * i + 2 * kr) * ldw + n0 + 4 * c4; ra[i] = *(const f32x4*)p; rb[i] = *(const f32x4*)(p + ldw); }
#pragma unroll
        for (int i = 0; i < 8; ++i) { const int k = kbase + 128 * hb + 16 * i + 2 * kr;
#pragma unroll
            for (int e = 0; e < 4; ++e) { mx[e] = fmaxf(mx[e], fmaxf(fabsf(ra[i][e]), fabsf(rb[i][e]))); *(LAS unsigned*)(lds + (4 * c4 + e) * PITCH + 2 * k) = pk2(ra[i][e], rb[i][e]); } } }
#pragma unroll
    for (int e = 0; e < 4; ++e) { mx[e] = fmaxf(mx[e], __shfl_xor(mx[e], 8)); mx[e] = fmaxf(mx[e], __shfl_xor(mx[e], 16)); mx[e] = fmaxf(mx[e], __shfl_xor(mx[e], 32)); }
    if (kr == 0) *(LAS f32x4*)(CM + wave * 32 + 4 * c4) = mx;
    __syncthreads();
    if (tid < 32) { float m = CM[tid];
#pragma unroll
        for (int w = 1; w < 8; ++w) m = fmaxf(m, CM[w * 32 + tid]);
        CM[256 + tid] = m; const int ng = n0 + tid; sw[mode == 0 ? ng : ((ng >> 7) << 8) + (ng & 127) + (mode == 2 ? 128 : 0)] = m * (1.0f / 127.0f); }
    __syncthreads();
    const int n = tid >> 4, kc = tid & 15; const float cmx = CM[256 + n], inv = cmx > 0.f ? 127.0f / cmx : 0.f;
    const int ng = n0 + n; unsigned char* orow = WT8 + (size_t)(mode == 0 ? ng : ((ng >> 7) << 8) + (ng & 127) + (mode == 2 ? 128 : 0)) * D;
#pragma unroll
    for (int q = 0; q < 8; ++q) { const int k = 16 * (kc + 16 * q); const u32x4 a = *(const LAS u32x4*)(lds + n * PITCH + 2 * k), b = *(const LAS u32x4*)(lds + n * PITCH + 2 * k + 16);
        const unsigned wv[8] = {a.x, a.y, a.z, a.w, b.x, b.y, b.z, b.w}; u32x4 o;
#pragma unroll
        for (int g = 0; g < 4; ++g) { const float f0 = fminf(fmaxf(__builtin_rintf(bflo(wv[2 * g]) * inv), -127.f), 127.f), f1 = fminf(fmaxf(__builtin_rintf(bfhi(wv[2 * g]) * inv), -127.f), 127.f),
                f2 = fminf(fmaxf(__builtin_rintf(bflo(wv[2 * g + 1]) * inv), -127.f), 127.f), f3 = fminf(fmaxf(__builtin_rintf(bfhi(wv[2 * g + 1]) * inv), -127.f), 127.f);
            o[g] = ((unsigned)(int)f0 & 255u) | (((unsigned)(int)f1 & 255u) << 8) | (((unsigned)(int)f2 & 255u) << 16) | ((unsigned)(int)f3 << 24); }
        *(u32x4*)(orow + k) = o; }
}
template <int OUT  >
__device__ __forceinline__ void norm_rows(const float* X, const float* gain, void* out, float* SA, int gw, int NGW, int lane) {
    f32x4 gv[8];
#pragma unroll
    for (int j = 0; j < 8; ++j) gv[j] = ((const f32x4*)gain)[lane + 64 * j];
    for (int m = gw; m < M; m += NGW) {
        const f32x4* xr = (const f32x4*)(X + (size_t)m * D) + lane; f32x4 v[8]; float s = 0.f;
#pragma unroll
        for (int j = 0; j < 8; ++j) { v[j] = xr[64 * j]; s += (v[j][0] * v[j][0] + v[j][1] * v[j][1]) + (v[j][2] * v[j][2] + v[j][3] * v[j][3]); }
        const float rstd = 1.0f / sqrtf(wave_sum(s) * (1.0f / D) + EPS);
        if (OUT == 1) { f32x4* o = (f32x4*)((float*)out + (size_t)m * D) + lane;
#pragma unroll
            for (int j = 0; j < 8; ++j) o[64 * j] = (v[j] * rstd) * gv[j];
        } else if (OUT == 2) { f32x4 y[8];
#pragma unroll
            for (int j = 0; j < 8; ++j) y[j] = (v[j] * rstd) * gv[j];
            store_row_q8(y, (unsigned char*)out, SA, m, lane);
        } else { u32x2* o = (u32x2*)((bf16_t*)out + (size_t)m * D) + lane;
#pragma unroll
            for (int j = 0; j < 8; ++j) { const f32x4 y = (v[j] * rstd) * gv[j]; u32x2 w; w.x = pk2(y[0], y[1]); w.y = pk2(y[2], y[3]); o[64 * j] = w; } }
    }
}

template <bool FINAL, bool XB16>
__device__ __forceinline__ void resnorm_rows(const float* base, const bf16_t* baseb, bool base16, const bf16_t* delta, float scale, const float* gain, float* X, bf16_t* XBo, bf16_t* Hout, int q8, unsigned char* H8out, float* SA, int gw, int NGW, int lane) {
    f32x4 gv[8];
#pragma unroll
    for (int j = 0; j < 8; ++j) gv[j] = ((const f32x4*)gain)[lane + 64 * j];
    for (int m = gw; m < M; m += NGW) {
        const u32x2* dr = (const u32x2*)(delta + (size_t)m * D) + lane; f32x4 v[8]; u32x2 dv[8]; float s = 0.f;
        if (XB16 && base16) { const u32x2* xr = (const u32x2*)(baseb + (size_t)m * D) + lane;
#pragma unroll
            for (int j = 0; j < 8; ++j) { const u32x2 w = xr[64 * j]; dv[j] = dr[64 * j]; v[j] = (f32x4){bflo(w.x), bfhi(w.x), bflo(w.y), bfhi(w.y)}; }
        } else { const f32x4* xr = (const f32x4*)(base + (size_t)m * D) + lane;
#pragma unroll
            for (int j = 0; j < 8; ++j) { v[j] = xr[64 * j]; dv[j] = dr[64 * j]; } }
#pragma unroll
        for (int j = 0; j < 8; ++j) { v[j][0] += scale * bflo(dv[j].x); v[j][1] += scale * bfhi(dv[j].x); v[j][2] += scale * bflo(dv[j].y); v[j][3] += scale * bfhi(dv[j].y);
            s += (v[j][0] * v[j][0] + v[j][1] * v[j][1]) + (v[j][2] * v[j][2] + v[j][3] * v[j][3]); }
        const float rstd = 1.0f / sqrtf(wave_sum(s) * (1.0f / D) + EPS);
        if (FINAL) { f32x4* xo = (f32x4*)(X + (size_t)m * D) + lane;
#pragma unroll
            for (int j = 0; j < 8; ++j) xo[64 * j] = (v[j] * rstd) * gv[j];
        } else { u32x2* o = (u32x2*)(Hout + (size_t)m * D) + lane;
            if (XB16) { u32x2* xo = (u32x2*)(XBo + (size_t)m * D) + lane;
#pragma unroll
                for (int j = 0; j < 8; ++j) { u32x2 w; w.x = pk2(v[j][0], v[j][1]); w.y = pk2(v[j][2], v[j][3]); xo[64 * j] = w; }
            } else { f32x4* xo = (f32x4*)(X + (size_t)m * D) + lane;
#pragma unroll
                for (int j = 0; j < 8; ++j) xo[64 * j] = v[j]; }
            f32x4 y[8];
#pragma unroll
            for (int j = 0; j < 8; ++j) y[j] = (v[j] * rstd) * gv[j];
            if (q8 != 1) {
#pragma unroll
                for (int j = 0; j < 8; ++j) { u32x2 w; w.x = pk2(y[j][0], y[j][1]); w.y = pk2(y[j][2], y[j][3]); o[64 * j] = w; } }
            if (q8 != 0) store_row_q8(y, H8out, SA, m, lane); }
    }
}


__device__ __forceinline__ void gmlp_phase(LAS unsigned char* lds, int l, const bf16_t* Z, bf16_t* Y, const float* vpart,
                                           const float* w_s, const float* b_s, const float* v_gain, int tid, int lane, int wave, int bx, int G) {
    constexpr int NU = BATCH * 32 * 8;
    if (bx >= NU) return;
    const int h = bx & 7;
    LAS unsigned char* VS = lds; LAS float* RS = (LAS float*)(lds + 128 * 272);
    const int fr = lane & 15, kg = lane >> 4, q = 16 * wave + fr;
    const int nks = (wave < 4) ? 2 : 4;
    f32x4 wraw[4][2];
    { const float* wrow = w_s + ((size_t)(l * 8 + h) * 128 + q) * 128 + 8 * kg;
#pragma unroll
      for (int ks = 0; ks < 4; ++ks) { wraw[ks][0] = *(const f32x4*)(wrow + 32 * ks); wraw[ks][1] = *(const f32x4*)(wrow + 32 * ks + 4); } }
    const float bias = b_s[(l * 8 + h) * 128 + q];
    f32x4 gn[8];
    { const float* grow = v_gain + l * DG + 128 * h + 4 * kg;
#pragma unroll
      for (int dt = 0; dt < 8; ++dt) gn[dt] = *(const f32x4*)(grow + 16 * dt); }
    const LAS unsigned char* trb = VS + (8 * kg + (fr >> 2)) * 272 + 8 * (lane & 3);
    const int vrow = tid >> 4, vch = tid & 15;
    f32x4 vp[4]; u32x4 vv[4]; u32x2 uu[8];
#define GMLP_LOAD(unit) do { const int m0_ = ((unit) >> 8) * SEQ + (((unit) >> 3) & 31) * 128; \
        { const f32x4* p_ = (const f32x4*)(vpart + (size_t)(m0_ + (tid & 127)) * 16); vp[0] = p_[0]; vp[1] = p_[1]; vp[2] = p_[2]; vp[3] = p_[3]; } \
        _Pragma("unroll") for (int pass = 0; pass < 4; ++pass) vv[pass] = *(const u32x4*)(Z + (size_t)(m0_ + vrow + 32 * pass) * DIN + DG + 128 * h + 8 * vch); \
        { const bf16_t* ur_ = Z + (size_t)(m0_ + q) * DIN + 128 * h + 4 * kg; _Pragma("unroll") for (int dt = 0; dt < 8; ++dt) uu[dt] = *(const u32x2*)(ur_ + 16 * dt); } } while (0)
    GMLP_LOAD(bx);
    for (int u = bx; u < NU; u += G) {
        const int m0 = (u >> 8) * SEQ + ((u >> 3) & 31) * 128;
        __syncthreads();
        if (tid < 128) { const float s = (((vp[0][0] + vp[0][1]) + (vp[0][2] + vp[0][3])) + ((vp[1][0] + vp[1][1]) + (vp[1][2] + vp[1][3]))) + (((vp[2][0] + vp[2][1]) + (vp[2][2] + vp[2][3])) + ((vp[3][0] + vp[3][1]) + (vp[3][2] + vp[3][3])));
            RS[tid] = 1.0f / sqrtf(s * (1.0f / DG) + EPS); }
#pragma unroll
        for (int pass = 0; pass < 4; ++pass) *(LAS u32x4*)(VS + (vrow + 32 * pass) * 272 + 16 * vch) = vv[pass];
        u32x2 uc[8];
#pragma unroll
        for (int dt = 0; dt < 8; ++dt) uc[dt] = uu[dt];
        { const int un = (u + G < NU) ? u + G : u; GMLP_LOAD(un); }
        __syncthreads();
        bf16x8 wf[4];
#pragma unroll
        for (int ks = 0; ks < 4; ++ks) {
            if (ks < nks) { const int p0 = 32 * ks + 8 * kg; const f32x4 r0 = *(const LAS f32x4*)(RS + p0), r1 = *(const LAS f32x4*)(RS + p0 + 4); const f32x4 w0 = wraw[ks][0] * r0, w1 = wraw[ks][1] * r1;
                u32x4 t; t.x = pk2(w0[0], w0[1]); t.y = pk2(w0[2], w0[3]); t.z = pk2(w1[0], w1[1]); t.w = pk2(w1[2], w1[3]); wf[ks] = __builtin_bit_cast(bf16x8, t);
            } else wf[ks] = (bf16x8){0, 0, 0, 0, 0, 0, 0, 0}; }
        bf16_t* yrow = Y + (size_t)(m0 + q) * D + 128 * h + 4 * kg;
#pragma unroll
        for (int dt = 0; dt < 8; ++dt) { f32x4 acc = {0.f, 0.f, 0.f, 0.f};
#pragma unroll
            for (int ks = 0; ks < 4; ++ks) if (ks < nks) {
                const LAS unsigned char* p = trb + (32 * ks) * 272 + 32 * dt;
                const s16x4 t0 = __builtin_amdgcn_ds_read_tr16_b64_v4i16((LAS s16x4*)p), t1 = __builtin_amdgcn_ds_read_tr16_b64_v4i16((LAS s16x4*)(p + 4 * 272));
                const bf16x8 vf = __builtin_shufflevector(t0, t1, 0, 1, 2, 3, 4, 5, 6, 7);
                acc = __builtin_amdgcn_mfma_f32_16x16x32_bf16(vf, wf[ks], acc, 0, 0, 0); }
            const float y0 = bflo(uc[dt].x) * (gn[dt][0] * acc[0] + bias), y1 = bfhi(uc[dt].x) * (gn[dt][1] * acc[1] + bias), y2 = bflo(uc[dt].y) * (gn[dt][2] * acc[2] + bias), y3 = bfhi(uc[dt].y) * (gn[dt][3] * acc[3] + bias);
            u32x2 w; w.x = pk2(y0, y1); w.y = pk2(y2, y3); *(u32x2*)(yrow + 16 * dt) = w; }
    }
#undef GMLP_LOAD
    __syncthreads();
}

template <int PASS>
__device__ __forceinline__ void lru_phase(LAS unsigned char* lds, int l, const bf16_t* Z, bf16_t* Y, float* summ, const bf16_t* lruw,
                                          const float* conv_w, const float* conv_b, const float* b_a, const float* b_x, const float* lam, int tid, int lane, int wave, int bx, int G) {
    constexpr int NU = BATCH * 64 * 8;
    if (bx >= NU) return;
    const int j = bx & 7, ch0 = 128 * j;
    LAS float* XC = (LAS float*)lds;
    LAS float* AS = (LAS float*)(lds + 33792);
    LAS unsigned char* XB = lds + 67584;
    LAS float* SEGS = (LAS float*)(lds + 84992);
    LAS float* PART = (LAS float*)(lds + 89088);
    const int chn = tid & 127, seg = tid >> 7;
    const int fr = lane & 15, kg = lane >> 4, chl = 16 * wave + 4 * kg;
    const int ct = tid >> 4, c8 = tid & 15;
    bf16x8 wa[4], wx[4];
    { const bf16_t* wbase = lruw + ((size_t)((l * 2 + 0) * 8 + j) * 128 + 16 * wave + fr) * 128 + 8 * kg;
#pragma unroll
      for (int ks = 0; ks < 4; ++ks) { wa[ks] = *(const bf16x8*)(wbase + 32 * ks); wx[ks] = *(const bf16x8*)(wbase + 8 * 128 * 128 + 32 * ks); } }
    const f32x4 bav = *(const f32x4*)(b_a + l * DG + ch0 + chl), bxv = *(const f32x4*)(b_x + l * DG + ch0 + chl);
    f32x4 spv; { const f32x4 lmv = *(const f32x4*)(lam + l * DG + ch0 + chl);
#pragma unroll
      for (int e = 0; e < 4; ++e) spv[e] = -8.0f * 1.4426950408889634f * log1pf(expf(-lmv[e])); }
    f32x4 cw[4][2], cb[2];
    { const float* cbp = conv_b + l * DG + ch0 + 8 * c8; cb[0] = *(const f32x4*)cbp; cb[1] = *(const f32x4*)(cbp + 4);
#pragma unroll
      for (int i = 0; i < 4; ++i) { const float* wp = conv_w + (size_t)(l * 4 + i) * DG + ch0 + 8 * c8; cw[i][0] = *(const f32x4*)wp; cw[i][1] = *(const f32x4*)(wp + 4); } }
    u32x4 xr[2][4]; u32x4 gg[2]; f32x2 sv[16];
#define LRU_LOAD(unit) do { const int c_ = ((unit) >> 3) & 63, b_ = (unit) >> 9; \
        _Pragma("unroll") for (int it0 = 0; it0 < 2; ++it0) _Pragma("unroll") for (int i = 0; i < 4; ++i) { const int tg = c_ * 64 + ct + 32 * it0 - 3 + i, tgc = tg < 0 ? 0 : tg; \
            xr[it0][i] = *(const u32x4*)(Z + (size_t)(b_ * SEQ + tgc) * DIN + 3 * DG + ch0 + 8 * c8); } \
        if (PASS == 1) { _Pragma("unroll") for (int it0 = 0; it0 < 2; ++it0) gg[it0] = *(const u32x4*)(Z + (size_t)(b_ * SEQ + c_ * 64 + ct + 32 * it0) * DIN + 2 * DG + ch0 + 8 * c8); \
            const float* sp_ = summ + ((size_t)(b_ * 64) * 1024 + ch0 + chn) * 2; \
            _Pragma("unroll") for (int k = 0; k < 16; ++k) { const int kk = seg * 16 + k, kc = kk < c_ ? kk : 0; sv[k] = *(const f32x2*)(sp_ + (size_t)kc * 2048); } } } while (0)
    LRU_LOAD(bx);
    for (int u = bx; u < NU; u += G) {
        const int c = (u >> 3) & 63, b = u >> 9, m0 = b * SEQ + c * 64;
        __syncthreads();
        if (PASS == 1) { float cP = 1.f, cH = 0.f;
#pragma unroll
            for (int k = 0; k < 16; ++k) { const bool on = (seg * 16 + k) < c; const float pa = on ? sv[k][0] : 1.f, ph = on ? sv[k][1] : 0.f; cH = pa * cH + ph; cP *= pa; }
            PART[(seg * 128 + chn) * 2] = cP; PART[(seg * 128 + chn) * 2 + 1] = cH; }
#pragma unroll
        for (int it0 = 0; it0 < 2; ++it0) { const int t = ct + 32 * it0; f32x4 a0 = cb[0], a1 = cb[1];
#pragma unroll
            for (int i = 0; i < 4; ++i) { u32x4 x = xr[it0][i]; if (c * 64 + t - 3 + i < 0) x = (u32x4){0u, 0u, 0u, 0u};
                a0[0] += cw[i][0][0] * bflo(x.x); a0[1] += cw[i][0][1] * bfhi(x.x); a0[2] += cw[i][0][2] * bflo(x.y); a0[3] += cw[i][0][3] * bfhi(x.y);
                a1[0] += cw[i][1][0] * bflo(x.z); a1[1] += cw[i][1][1] * bfhi(x.z); a1[2] += cw[i][1][2] * bflo(x.w); a1[3] += cw[i][1][3] * bfhi(x.w); }
            *(LAS f32x4*)(XC + t * 132 + 8 * c8) = a0; *(LAS f32x4*)(XC + t * 132 + 8 * c8 + 4) = a1;
            u32x4 pw; pw.x = pk2(a0[0], a0[1]); pw.y = pk2(a0[2], a0[3]); pw.z = pk2(a1[0], a1[1]); pw.w = pk2(a1[2], a1[3]);
            *(LAS u32x4*)(XB + t * 272 + 16 * c8) = pw; }
        u32x4 gc[2]; if (PASS == 1) { gc[0] = gg[0]; gc[1] = gg[1]; }
        { const int un = (u + G < NU) ? u + G : u; LRU_LOAD(un); }
        __syncthreads();
#pragma unroll
        for (int tt = 0; tt < 4; ++tt) { f32x4 accA = {0.f, 0.f, 0.f, 0.f}, accX = {0.f, 0.f, 0.f, 0.f};
#pragma unroll
            for (int ks = 0; ks < 4; ++ks) { const bf16x8 xf = *(const LAS bf16x8*)(XB + (16 * tt + fr) * 272 + (32 * ks + 8 * kg) * 2);
                accA = __builtin_amdgcn_mfma_f32_16x16x32_bf16(wa[ks], xf, accA, 0, 0, 0); accX = __builtin_amdgcn_mfma_f32_16x16x32_bf16(wx[ks], xf, accX, 0, 0, 0); }
            const int t = 16 * tt + fr; const f32x4 xcv = *(const LAS f32x4*)(XC + t * 132 + chl); f32x4 av, gv;
#pragma unroll
            for (int e = 0; e < 4; ++e) { const float r = sigmoid_f(accA[e] + bav[e]), ig = sigmoid_f(accX[e] + bxv[e]);
                const float l2a = r * spv[e];
                const float a = __builtin_amdgcn_exp2f(l2a);
                const float y = l2a * (2.0f * 0.6931471805599453f);
                float p = 1.0f + y * (1.0f / 7.0f); p = 1.0f + (y * (1.0f / 6.0f)) * p; p = 1.0f + (y * 0.2f) * p; p = 1.0f + (y * 0.25f) * p; p = 1.0f + (y * (1.0f / 3.0f)) * p; p = 1.0f + (y * 0.5f) * p;
                const float em = (y > -0.5f) ? -(y * p) : (1.0f - a * a);
                av[e] = a; gv[e] = __builtin_amdgcn_sqrtf(em) * (ig * xcv[e]); }
            *(LAS f32x4*)(AS + t * 132 + chl) = av; *(LAS f32x4*)(XC + t * 132 + chl) = gv; }
        __syncthreads();
        float P = 1.f, H = 0.f;
#pragma unroll
        for (int k = 0; k < 16; ++k) { const int t = 16 * seg + k; const float a = AS[t * 132 + chn], g = XC[t * 132 + chn]; H = a * H + g; P *= a; }
        SEGS[(seg * 128 + chn) * 2] = P; SEGS[(seg * 128 + chn) * 2 + 1] = H;
        __syncthreads();
        if (PASS == 0) {
            if (tid < 128) { float p = 1.f, hh = 0.f;
#pragma unroll
                for (int s = 0; s < 4; ++s) { const float ps = SEGS[(s * 128 + chn) * 2], hs = SEGS[(s * 128 + chn) * 2 + 1]; hh = ps * hh + hs; p *= ps; }
                *(f32x2*)(summ + ((size_t)(b * 64 + c) * 1024 + ch0 + chn) * 2) = (f32x2){p, hh}; }
        } else {
            float hh = 0.f;
#pragma unroll
            for (int s = 0; s < 4; ++s) hh = PART[(s * 128 + chn) * 2] * hh + PART[(s * 128 + chn) * 2 + 1];
#pragma unroll
            for (int s = 0; s < 3; ++s) if (s < seg) hh = SEGS[(s * 128 + chn) * 2] * hh + SEGS[(s * 128 + chn) * 2 + 1];
#pragma unroll
            for (int k = 0; k < 16; ++k) { const int t = 16 * seg + k; const float a = AS[t * 132 + chn], g = XC[t * 132 + chn]; hh = a * hh + g; XC[t * 132 + chn] = hh; }
            __syncthreads();
#pragma unroll
            for (int it0 = 0; it0 < 2; ++it0) { const int t = ct + 32 * it0;
                const f32x4 h0 = *(const LAS f32x4*)(XC + t * 132 + 8 * c8), h1 = *(const LAS f32x4*)(XC + t * 132 + 8 * c8 + 4);
                const u32x4 g4 = gc[it0];
                u32x4 w; w.x = pk2(h0[0] * bflo(g4.x), h0[1] * bfhi(g4.x)); w.y = pk2(h0[2] * bflo(g4.y), h0[3] * bfhi(g4.y));
                w.z = pk2(h1[0] * bflo(g4.z), h1[1] * bfhi(g4.z)); w.w = pk2(h1[2] * bflo(g4.w), h1[3] * bfhi(g4.w));
                *(u32x4*)(Y + (size_t)(m0 + t) * D + DG + ch0 + 8 * c8) = w; }
        }
    }
#undef LRU_LOAD
    __syncthreads();
}

struct Args { const float* in[23]; float* out; unsigned char* ws; int ph_lo, ph_hi, li, pad; };
typedef const Args __attribute__((address_space(4))) CArgs;
#define GETARGS() CArgs* ap = (CArgs*)__builtin_amdgcn_kernarg_segment_ptr(); asm volatile("" : "+s"(ap))
__global__ void __launch_bounds__(NWAVES * 64, 2) mk_fwd(Args args_unused) {
    extern __shared__ __attribute__((aligned(16))) unsigned char lds_raw[];
    LAS unsigned char* lds = (LAS unsigned char*)lds_raw;
    for (int u = threadIdx.x; u < (LDS_BYTES - LDSCTL_OFF) / 4; u += NWAVES * 64) ((LAS unsigned*)(lds + LDSCTL_OFF))[u] = 0u;
    __syncthreads();
    int lo, hi;
    { GETARGS(); lo = ap->ph_lo; hi = ap->ph_hi; (void)xcd_barrier_post((unsigned*)(ap->ws + WS_CTL) + CW_BAR + ap->li * XCD_BAR_WORDS, (volatile LAS unsigned*)(lds + MISC_OFF) + 8); }
    int ph = 0;
#define PH_ON (lo <= ph && ph < hi)
#define PH_END do { if (lo <= ph && ph + 1 < hi) { GETARGS(); XcdBarrier bb; bb.bar = (unsigned*)(ap->ws + WS_CTL) + CW_BAR + ap->li * XCD_BAR_WORDS; bb.x = xb_xcc_id(); bb.st = (volatile LAS unsigned*)(lds + MISC_OFF) + 8; xcd_barrier(bb); } ++ph; } while (0)
#define GEOM() int tid = threadIdx.x; asm volatile("" : "+v"(tid)); const int lane = tid & 63, wave = __builtin_amdgcn_readfirstlane(tid >> 6); (void)lane; const int G = gridDim.x, bx = blockIdx.x; const int vcu = (G % 8 == 0) ? (bx % 8) * (G / 8) + bx / 8 : bx; const int gw = vcu * NWAVES + wave, NGW = G * NWAVES; (void)gw; (void)NGW; (void)vcu

    if (PH_ON) {
        GETARGS(); GEOM(); unsigned char* ws = ap->ws;
        constexpr int I_F = (D / 64) * (DFF / 64), I_IN = (D / 64) * (NBF / 64), I_OUT = (D / 64) * (D / 64);
        constexpr int NSTRIP_F = 8 * (DFF / 32), NSTRIP = NSTRIP_F + 2 * (N8 / 32), NB = 4 * I_F, NC = 2 * I_IN, ND = 2 * I_OUT, NITEM = NB + NC + ND;
        for (int rep = 0; rep < REP_PRO; ++rep) {
        for (int st = bx; st < NSTRIP; st += G) {
            if (st >= NSTRIP_F) { const int r = st - NSTRIP_F, l = r / (N8 / 32), sc = r - l * (N8 / 32);
                strip_q8(ap->in[6] + (size_t)l * D * DIN + NBF, DIN, ws + WS_WIN + (size_t)l * SZ_WIN * 2 + (size_t)NBF * D * 2, 0, (float*)(ws + WS_SWIN) + (size_t)l * N8, lds, sc, tid, lane, wave); continue; }
            const int mat = st / (DFF / 32), sc = st - mat * (DFF / 32), l = mat >> 2, f = (mat >> 1) & 1, up = mat & 1;
            strip_q8((f ? (up ? ap->in[20] : ap->in[19]) : (up ? ap->in[3] : ap->in[2])) + (size_t)l * D * DFF, DFF, ws + WS_WGU + (size_t)(l * 2 + f) * SZ_WGU8, up ? 2 : 1, (float*)(ws + WS_SW) + (size_t)(l * 2 + f) * 2 * DFF, lds, sc, tid, lane, wave); }
        __syncthreads();
        bf16_t* WD = (bf16_t*)(ws + WS_WD); bf16_t* WIN = (bf16_t*)(ws + WS_WIN); bf16_t* WOUT = (bf16_t*)(ws + WS_WOUT);
        LAS unsigned* scr = (LAS unsigned*)(lds + wave * 8448);
        const int nshort = (NSTRIP % G) ? G - NSTRIP % G : 0, nextra = nshort * NWAVES * 2 < NITEM ? nshort * NWAVES * 2 : 0;
        for (int pass = 0; pass < 2; ++pass) {
            int it, step, end;
            if (pass == 0) { if (nextra == 0 || bx < G - nshort) continue; it = ((bx - (G - nshort)) * NWAVES + wave) * 2; step = 1; end = it + 2; }
            else { it = nextra + gw; step = NGW; end = NITEM; }
            for (; it < end; it += step) { int r = it;
                if (r < NB) { const int idx = r / I_F, l = idx >> 1, f = idx & 1; r -= idx * I_F; tr_item((f ? ap->in[21] : ap->in[4]) + (size_t)l * D * DFF, DFF, D, D, WD + (size_t)idx * SZ_WD, 0, scr, r, lane); continue; } r -= NB;
                if (r < NC) { const int l = r / I_IN; r -= l * I_IN; tr_item(ap->in[6] + (size_t)l * D * DIN, D, NBF, DIN, WIN + (size_t)l * SZ_WIN, 0, scr, r, lane); continue; } r -= NC;
                { const int l = r / I_OUT; r -= l * I_OUT; tr_item(ap->in[17] + (size_t)l * D * D, D, D, D, WOUT + (size_t)l * SZ_WOUT, 0, scr, r, lane); } } }
        }
        bf16_t* lruw = (bf16_t*)(ws + WS_LRUW);
        for (int o = vcu * 512 + tid; o < 2 * 2 * 8 * 128 * 128; o += G * 512) {
            const int i = o & 127, jj = (o >> 7) & 127, hh = (o >> 14) & 7, which = (o >> 17) & 1, l = o >> 18;
            const float* src = which ? ap->in[14] : ap->in[12];
            lruw[o] = (bf16_t)(pk2(src[((size_t)(l * 8 + hh) * 128 + i) * 128 + jj], 0.f) & 0xffffu); }
        for (int rep = 0; rep < REP_NORM; ++rep) norm_rows<2>(ap->in[0], ap->in[1], (void*)(ws + WS_H), (float*)(ws + WS_SA), gw, NGW, lane);
    }
    PH_END;

#pragma nounroll
    for (int i = 0; i < 4; ++i) {
        if (PH_ON) { GETARGS(); GEOM(); unsigned char* ws = ap->ws;
            pg8::Gemm g{(bf16_t*)(ws + WS_H), (bf16_t*)(ws + WS_WGU + (size_t)i * SZ_WGU8), M, 2 * DFF, D / 2}; pg8::StaticOrder S; S.init(M, 2 * DFF, G, bx);
            const float* sa = (const float*)(ws + WS_SA); const float* sw = (const float*)(ws + WS_SW) + (size_t)i * 2 * DFF;
            LAS float* tab = (LAS float*)(lds + SCALE_TAB_OFF);
            if (G == 256) { const int pm = 8 * (bx & 7) + ((bx >> 3) & 7);
                for (int t = tid; t < 256; t += NWAVES * 64) tab[t] = sa[256 * pm + t];
                for (int t = tid; t < 11 * 256; t += NWAVES * 64) tab[256 + t] = sw[256 * (4 * (t >> 8) + (bx >> 6)) + (t & 255)];
                __syncthreads(); }
            pg8::EpiSwiGLU8 E{(bf16_t*)(ws + WS_ACT), DFF, sa, sw, G == 256 ? (PG8_LAS const float*)tab : (PG8_LAS const float*)nullptr};
            for (int rep = 0; rep < REP_GU; ++rep) pg8::gemm_phase<pg8::EpiSwiGLU8, pg8::StaticOrder, PG8_ALIGN, PG8_SP2, true>(lds, g, S, E); }
        PH_END;
        if (PH_ON) { GETARGS(); GEOM(); unsigned char* ws = ap->ws;
            pg8::Gemm g{(bf16_t*)(ws + WS_ACT), (bf16_t*)(ws + WS_WD) + (size_t)i * SZ_WD, M, D, DFF}; pg8::StaticOrder S; S.init(M, D, G, bx);
            pg8::EpiDelta E{(bf16_t*)(ws + WS_DELTA), D}; for (int rep = 0; rep < REP_DOWN; ++rep) pg8::gemm_phase<pg8::EpiDelta, pg8::StaticOrder, PG8_ALIGN, PG8_SP2>(lds, g, S, E); }
        PH_END;
        if (PH_ON) { GETARGS(); GEOM(); const bf16_t* dl = (const bf16_t*)(ap->ws + WS_DELTA);
            if (i == 3) resnorm_rows<true, XBF16 != 0>(ap->out, (const bf16_t*)(ap->ws + WS_XB), true, dl, 0.5f, ap->in[22], ap->out, nullptr, nullptr, 0, nullptr, nullptr, gw, NGW, lane);
            else for (int rep = 0; rep < REP_NORM; ++rep) resnorm_rows<false, XBF16 != 0>((i == 0 && rep == 0) ? ap->in[0] : (const float*)ap->out, (const bf16_t*)(ap->ws + WS_XB), !(i == 0 && rep == 0), dl, rep == 0 ? 0.5f : 0.0f, (i & 1) == 0 ? ap->in[5] + (size_t)(i >> 1) * D : ap->in[1] + (size_t)D, ap->out, (bf16_t*)(ap->ws + WS_XB), (bf16_t*)(ap->ws + WS_H), i == 1 ? 1 : (N8 > 0 ? 2 : 0), ap->ws + (i == 1 ? WS_H : WS_Y), (float*)(ap->ws + WS_SA), gw, NGW, lane);
        }
        PH_END;
        if ((i & 1) == 0) {
            const int l = i >> 1;
            if (PH_ON) { GETARGS(); GEOM(); unsigned char* ws = ap->ws;
                const float* sa = (const float*)(ws + WS_SA); const float* sw = (const float*)(ws + WS_SWIN) + (size_t)l * N8;
                LAS float* tab = (LAS float*)(lds + SCALE_TAB_OFF);
                if (N8 > 0 && G == 256) { const int pm = 8 * (bx & 7) + ((bx >> 3) & 7);
                    for (int t = tid; t < 256; t += NWAVES * 64) tab[t] = sa[256 * pm + t];
                    for (int t = tid; t < (N8 / 1024) * 256; t += NWAVES * 64) tab[256 + t] = sw[256 * (4 * (t >> 8) + (bx >> 6)) + (t & 255)];
                    __syncthreads(); }
                for (int rep = 0; rep < REP_WIN; ++rep) {
                if (NBF > 0) { pg8::Gemm g{(bf16_t*)(ws + WS_H), (bf16_t*)(ws + WS_WIN) + (size_t)l * SZ_WIN, M, NBF, D}; pg8::StaticOrder S; S.init(M, NBF, G, bx);
                    pg8::EpiWin E{(bf16_t*)(ws + WS_ACT), DIN, (float*)(ws + WS_VPART)}; pg8::gemm_phase<pg8::EpiWin, pg8::StaticOrder, PG8_ALIGN, PG8_SP2>(lds, g, S, E); }
                if (N8 > 0) { pg8::Gemm g{(bf16_t*)(ws + WS_Y), (bf16_t*)(ws + WS_WIN + (size_t)l * SZ_WIN * 2 + (size_t)NBF * D * 2), M, N8, D / 2}; pg8::StaticOrder S; S.init(M, N8, G, bx);
                    pg8::EpiWin8 E{(bf16_t*)(ws + WS_ACT), DIN, (float*)(ws + WS_VPART), sa, sw, NBF / 256, G == 256 ? (PG8_LAS const float*)tab : (PG8_LAS const float*)nullptr};
                    pg8::gemm_phase<pg8::EpiWin8, pg8::StaticOrder, PG8_ALIGN, PG8_SP2, true>(lds, g, S, E); }
                } }
            PH_END;
            if (PH_ON) { GETARGS(); GEOM(); unsigned char* ws = ap->ws;
                for (int rep = 0; rep < REP_MIXA; ++rep) {
                gmlp_phase(lds, l, (const bf16_t*)(ws + WS_ACT), (bf16_t*)(ws + WS_Y), (const float*)(ws + WS_VPART), ap->in[8], ap->in[9], ap->in[7], tid, lane, wave, bx, G);
                lru_phase<0>(lds, l, (const bf16_t*)(ws + WS_ACT), (bf16_t*)(ws + WS_Y), (float*)(ws + WS_SUMM), (const bf16_t*)(ws + WS_LRUW), ap->in[10], ap->in[11], ap->in[13], ap->in[15], ap->in[16], tid, lane, wave, bx, G);
                }
            }
            PH_END;
            if (PH_ON) { GETARGS(); GEOM(); unsigned char* ws = ap->ws;
                for (int rep = 0; rep < REP_MIXB; ++rep)
                lru_phase<1>(lds, l, (const bf16_t*)(ws + WS_ACT), (bf16_t*)(ws + WS_Y), (float*)(ws + WS_SUMM), (const bf16_t*)(ws + WS_LRUW), ap->in[10], ap->in[11], ap->in[13], ap->in[15], ap->in[16], tid, lane, wave, bx, G);
            }
            PH_END;
            if (PH_ON) { GETARGS(); GEOM(); unsigned char* ws = ap->ws;
                pg8::Gemm g{(bf16_t*)(ws + WS_Y), (bf16_t*)(ws + WS_WOUT) + (size_t)l * SZ_WOUT, M, D, D}; pg8::StaticOrder S; S.init(M, D, G, bx);
                pg8::EpiDelta E{(bf16_t*)(ws + WS_DELTA), D}; for (int rep = 0; rep < REP_WOUT; ++rep) pg8::gemm_phase<pg8::EpiDelta, pg8::StaticOrder, PG8_ALIGN, PG8_SP2>(lds, g, S, E); }
            PH_END;
            if (PH_ON) { GETARGS(); GEOM(); for (int rep = 0; rep < REP_NORM; ++rep) resnorm_rows<false, XBF16 != 0>(ap->out, (const bf16_t*)(ap->ws + WS_XB), true, (const bf16_t*)(ap->ws + WS_DELTA), rep == 0 ? 1.0f : 0.0f, ap->in[18] + (size_t)l * D, ap->out, (bf16_t*)(ap->ws + WS_XB), (bf16_t*)(ap->ws + WS_H), 1, ap->ws + WS_H, (float*)(ap->ws + WS_SA), gw, NGW, lane); }
            PH_END;
        }
    }
#if defined(DUMMY_N) && DUMMY_N > 0
    if (PH_ON) { GETARGS(); GEOM(); unsigned char* ws = ap->ws;
#if defined(DUMMY_I8) && DUMMY_I8
        pg8::Gemm g{(bf16_t*)(ws + WS_H), (bf16_t*)(ws + WS_WGU), M, DUMMY_N, D / 2}; pg8::StaticOrder S; S.init(M, DUMMY_N, G, bx);
        pg8::EpiDummyI8 E{(bf16_t*)(ws + WS_ACT), DUMMY_N}; pg8::gemm_phase<pg8::EpiDummyI8, pg8::StaticOrder, PG8_ALIGN, PG8_SP2, true>(lds, g, S, E);
#else
        pg8::Gemm g{(bf16_t*)(ws + WS_H), (bf16_t*)(ws + WS_WGU), M, DUMMY_N, D}; pg8::StaticOrder S; S.init(M, DUMMY_N, G, bx);
        pg8::EpiDelta E{(bf16_t*)(ws + WS_ACT), DUMMY_N}; pg8::gemm_phase<pg8::EpiDelta, pg8::StaticOrder, PG8_ALIGN, PG8_SP2>(lds, g, S, E);
#endif
    }
    PH_END;
#endif
#undef PH_ON
#undef PH_END
}

extern "C" void kernel_launch(void* const* d_in, const int* in_sizes, int n_in, void* d_out, int out_size, void* d_ws, size_t ws_size, hipStream_t stream) {
    static int grid = 0;
    if (grid == 0) {
        if (n_in != 23 || in_sizes[0] != M * D || out_size != M * D || ws_size < WS_END) { fprintf(stderr, "kernel_launch: unexpected shapes (n_in %d, in0 %d, out %d, ws %zu); nothing launched\n", n_in, n_in > 0 ? in_sizes[0] : -1, out_size, ws_size); grid = -1; return; }
        int dev = 0, cus = 0;
        if (hipGetDevice(&dev) != hipSuccess || hipDeviceGetAttribute(&cus, hipDeviceAttributeMultiprocessorCount, dev) != hipSuccess) { fprintf(stderr, "kernel_launch: device query failed\n"); grid = -1; return; }
        if (hipFuncSetAttribute((const void*)mk_fwd, hipFuncAttributeMaxDynamicSharedMemorySize, LDS_BYTES) != hipSuccess) { fprintf(stderr, "kernel_launch: hipFuncSetAttribute failed\n"); grid = -1; return; }
        int per_cu = 0;
        if (hipOccupancyMaxActiveBlocksPerMultiprocessor(&per_cu, (const void*)mk_fwd, NWAVES * 64, LDS_BYTES) != hipSuccess || per_cu < 1) fprintf(stderr, "kernel_launch: note: occupancy query reports %d workgroups per CU\n", per_cu);
        (void)hipGetLastError();
        grid = cus - cus % 8;
    }
    if (grid < 0) return;
    if (hipMemsetAsync((char*)d_ws + WS_CTL, 0, CTL_ZERO_BYTES, stream) != hipSuccess) { fprintf(stderr, "kernel_launch: memset failed\n"); return; }
    Args a{};
    for (int i = 0; i < 23; ++i) a.in[i] = (const float*)d_in[i];
    a.out = (float*)d_out; a.ws = (unsigned char*)d_ws; a.pad = 0;
#if MK_MODE == 0
    a.ph_lo = 0; a.ph_hi = NPH; a.li = 0;
    hipLaunchKernelGGL(mk_fwd, dim3(grid), dim3(NWAVES * 64), LDS_BYTES, stream, a);
#else
    for (int p = 0; p < NPH; ++p) { a.ph_lo = p; a.ph_hi = p + 1; a.li = p; hipLaunchKernelGGL(mk_fwd, dim3(grid), dim3(NWAVES * 64), LDS_BYTES, stream, a); }
#endif
}
```
